# Optimizing an MI355X kernel written in HIP

```python
import math
import jax, jax.numpy as jnp
from jax import lax
import numpy as np

D_MODEL = 2048
BATCH = 4
SEQ = 4096
DEPTH = 4

CHUNK = 64
Q_BLOCK = 128
N_MIXERS = 2
N_A = (DEPTH + 1) // 2
N_B = DEPTH // 2

SB_HEADS = 16
SB_HEAD_DIM = D_MODEL // SB_HEADS
SB_IN = 3 * SB_HEADS * SB_HEAD_DIM

DSA_HEADS = 16
DSA_KV_HEADS = 4
DSA_GROUP = DSA_HEADS // DSA_KV_HEADS
DSA_HEAD_DIM = D_MODEL // DSA_HEADS
IDX_HEADS = 16
IDX_HEAD_DIM = 64
IDX_TOPK_MAX = 256
DSA_SIZES = (DSA_HEADS * DSA_HEAD_DIM,
             DSA_KV_HEADS * DSA_HEAD_DIM,
             DSA_KV_HEADS * DSA_HEAD_DIM,
             IDX_HEADS * IDX_HEAD_DIM,
             IDX_HEAD_DIM,
             IDX_HEADS)
DSA_IN = sum(DSA_SIZES)

REL_BUCKETS = 32
REL_MAX_DIST = 128

D_FF = 4 * D_MODEL
RMS_EPS = 1e-6

kernel_name = "hybrid_stickbreak_dsa_streaming_trunk"


def rms_norm(x, g):
    xf = x.astype(jnp.float32)
    y = xf * lax.rsqrt(jnp.mean(xf * xf, axis=-1, keepdims=True) + RMS_EPS)
    return (y * g.astype(jnp.float32)).astype(x.dtype)


def t5_bucket(rel):
    half = REL_BUCKETS // 2
    max_exact = half // 2
    n = jnp.abs(rel)
    nf = jnp.maximum(n, max_exact).astype(jnp.float32)
    large = max_exact + (jnp.log(nf / max_exact) / math.log(REL_MAX_DIST / max_exact)
                         * (half - max_exact)).astype(jnp.int32)
    large = jnp.minimum(large, half - 1)
    return jnp.where(rel > 0, half, 0) + jnp.where(n < max_exact, n, large)


def stick_breaking_mixer(h, w_in, w_out):
    b, s, _ = h.shape
    q, k, v = jnp.split(h @ w_in, 3, axis=-1)
    q = q.reshape(b, s, SB_HEADS, SB_HEAD_DIM)
    k = k.reshape(b, s, SB_HEADS, SB_HEAD_DIM)
    v = v.reshape(b, s, SB_HEADS, SB_HEAD_DIM)
    scale = SB_HEAD_DIM ** -0.5
    outs = []
    for i in range(s // Q_BLOCK):
        q0 = i * Q_BLOCK
        q1 = q0 + Q_BLOCK
        z = jnp.einsum('bqhd,bkhd->bhqk', q[:, q0:q1], k[:, :q1],
                       preferred_element_type=jnp.float32) * scale
        t_pos = q0 + jnp.arange(Q_BLOCK)[:, None]
        s_pos = jnp.arange(q1)[None, :]
        causal = s_pos < t_pos
        log_1mb = jnp.where(causal, jax.nn.log_sigmoid(-z), 0.0)
        tail = lax.cumsum(log_1mb, axis=3, reverse=True) - log_1mb
        a = jnp.where(causal, jnp.exp(jax.nn.log_sigmoid(z) + tail), 0.0)
        outs.append(jnp.einsum('bhqk,bkhd->bqhd', a.astype(v.dtype), v[:, :q1]))
    o = jnp.concatenate(outs, axis=1).reshape(b, s, SB_HEADS * SB_HEAD_DIM)
    return o @ w_out


def dsa_mixer(h, w_in, w_out, q_gain, k_gain, rel_bias):
    b, s, _ = h.shape
    topk = min(IDX_TOPK_MAX, s // 4)
    splits = np.cumsum(DSA_SIZES)[:-1].tolist()
    q, k, v, qi, ki, wi = jnp.split(h @ w_in, splits, axis=-1)
    q = rms_norm(q.reshape(b, s, DSA_HEADS, DSA_HEAD_DIM), q_gain)
    k = rms_norm(k.reshape(b, s, DSA_KV_HEADS, DSA_HEAD_DIM), k_gain)
    v = v.reshape(b, s, DSA_KV_HEADS, DSA_HEAD_DIM)
    qi = qi.reshape(b, s, IDX_HEADS, IDX_HEAD_DIM)
    wi = wi.astype(jnp.float32) * IDX_HEADS ** -0.5
    idx_scale = IDX_HEAD_DIM ** -0.5
    att_scale = DSA_HEAD_DIM ** -0.5
    gather = jax.vmap(lambda arr, ind: arr[ind])
    outs = []
    for i in range(s // Q_BLOCK):
        q0 = i * Q_BLOCK
        q1 = q0 + Q_BLOCK
        t_pos = q0 + jnp.arange(Q_BLOCK)
        chunk_end = (t_pos // CHUNK + 1) * CHUNK
        admiss = jnp.arange(q1)[None, :] < chunk_end[:, None]
        dots = jnp.einsum('bqhd,bkd->bqhk', qi[:, q0:q1], ki[:, :q1],
                          preferred_element_type=jnp.float32) * idx_scale
        score = jnp.einsum('bqh,bqhk->bqk', wi[:, q0:q1], jax.nn.relu(dots))
        score = jnp.where(admiss[None], score, -jnp.inf)
        kb = min(topk, q1)
        _, sel = lax.top_k(score, kb)
        valid = sel < chunk_end[None, :, None]
        k_sel = gather(k[:, :q1], sel)
        v_sel = gather(v[:, :q1], sel)
        qg = q[:, q0:q1].reshape(b, Q_BLOCK, DSA_KV_HEADS, DSA_GROUP, DSA_HEAD_DIM)
        logits = jnp.einsum('bqngd,bqjnd->bqngj', qg, k_sel,
                            preferred_element_type=jnp.float32) * att_scale
        bias = rel_bias[:, t5_bucket(sel - t_pos[None, :, None])]
        bias = bias.reshape(DSA_KV_HEADS, DSA_GROUP, b, Q_BLOCK, kb).transpose(2, 3, 0, 1, 4)
        logits = jnp.where(valid[:, :, None, None, :], logits + bias.astype(jnp.float32), -jnp.inf)
        p = jax.nn.softmax(logits, axis=-1)
        o = jnp.einsum('bqngj,bqjnd->bqngd', p.astype(v.dtype), v_sel)
        outs.append(o.reshape(b, Q_BLOCK, DSA_HEADS * DSA_HEAD_DIM))
    o = jnp.concatenate(outs, axis=1)
    return o @ w_out


def setup_inputs(seed: int = 0) -> dict:
    key = jax.random.key(seed)
    ks = jax.random.split(key, 13)
    f32 = jnp.float32
    d_in = D_MODEL ** -0.5
    return {
        "x": jax.random.normal(ks[0], (BATCH, SEQ, D_MODEL), f32),
        "norm_mix": 1.0 + 0.02 * jax.random.normal(ks[1], (DEPTH, D_MODEL), f32),
        "w_in_a": jax.random.normal(ks[2], (N_A, D_MODEL, SB_IN), f32) * d_in,
        "w_out_a": jax.random.normal(ks[3], (N_A, SB_HEADS * SB_HEAD_DIM, D_MODEL), f32) * (SB_HEADS * SB_HEAD_DIM) ** -0.5,
        "w_in_b": jax.random.normal(ks[4], (N_B, D_MODEL, DSA_IN), f32) * d_in,
        "w_out_b": jax.random.normal(ks[5], (N_B, DSA_HEADS * DSA_HEAD_DIM, D_MODEL), f32) * (DSA_HEADS * DSA_HEAD_DIM) ** -0.5,
        "q_norm_b": 1.0 + 0.02 * jax.random.normal(ks[6], (N_B, DSA_HEAD_DIM), f32),
        "k_norm_b": 1.0 + 0.02 * jax.random.normal(ks[7], (N_B, DSA_HEAD_DIM), f32),
        "rel_bias": 0.5 * jax.random.normal(ks[8], (DSA_HEADS, REL_BUCKETS), f32),
        "norm_mlp": 1.0 + 0.02 * jax.random.normal(ks[9], (DEPTH, D_MODEL), f32),
        "w_up": jax.random.normal(ks[10], (DEPTH, D_MODEL, D_FF), f32) * d_in,
        "w_down": jax.random.normal(ks[11], (DEPTH, D_FF, D_MODEL), f32) * D_FF ** -0.5,
    }


def reference(x, norm_mix, w_in_a, w_out_a, w_in_b, w_out_b, q_norm_b, k_norm_b,
              rel_bias, norm_mlp, w_up, w_down):
    for i in range(DEPTH):
        h = rms_norm(x, norm_mix[i])
        j = i // N_MIXERS
        if i % N_MIXERS == 0:
            x = x + stick_breaking_mixer(h, w_in_a[j], w_out_a[j])
        else:
            x = x + dsa_mixer(h, w_in_b[j], w_out_b[j], q_norm_b[j], k_norm_b[j], rel_bias)
        h = rms_norm(x, norm_mlp[i])
        x = x + jnp.square(jax.nn.relu(h @ w_up[i])) @ w_down[i]
    return x
```

```cpp
#include <hip/hip_runtime.h>
#include <hip/hip_cooperative_groups.h>
#include <cstdio>
#include <cstdint>
namespace cg = cooperative_groups;
namespace pg8 {
#define PG8_LAS __attribute__((address_space(3)))
typedef unsigned short bf16_t;
typedef short bf16x8 __attribute__((ext_vector_type(8)));
typedef float f32x4 __attribute__((ext_vector_type(4)));
typedef unsigned u32x4 __attribute__((ext_vector_type(4)));
constexpr int BM = 256, BK = 64, HALF = 128, HTB = HALF * BK * 2  , STAGE_BYTES = 8 * HTB, NXCD = 8, WGM = 8;

__host__ __device__ __forceinline__ int lds_byte(int r, int c) { const int st = (r >> 4) * 2 + (c >> 5), rr = r & 15, cc = c & 31, ob = rr * 64 + cc * 2; return st * 1024 + (ob ^ (((ob >> 9) & 1) << 5)); }
__host__ __device__ __forceinline__ void stage_rc(int b, int& R, int& C) { const int st = b / 1024, sb = b % 1024, swz = sb ^ (((sb >> 9) & 1) << 5); R = (st >> 1) * 16 + swz / 64; C = (st & 1) * 32 + (swz % 64) / 2; }
__host__ __device__ __forceinline__ int perm32(int rho) { const int n = rho >> 4, i = rho & 15; return 8 * (i >> 2) + 4 * n + (i & 3); }

struct Unit { int pm, pn; };
struct Gemm { const bf16_t* A; const bf16_t* Bt; int M, N, K; };

struct StaticOrder {
    int nM, nN, nwg, G, c;
    __host__ __device__ void init(int M, int N, int G_, int c_) { nM = M / BM; nN = N / BM; nwg = nM * nN; G = G_; c = c_; }
    __host__ __device__ bool next(int i, Unit& u) const {
        const long L = (long)i * G + c; if (L >= nwg) return false;
        int wgid = (int)L; { const int q = nwg / NXCD, r = nwg % NXCD, xcd = wgid % NXCD, off = wgid / NXCD; wgid = (xcd < r ? xcd * (q + 1) : r * (q + 1) + (xcd - r) * q) + off; }
        const int nig = WGM * nN, gid = wgid / nig, fm = gid * WGM, gsz = (nM - fm) < WGM ? (nM - fm) : WGM;
        u.pm = fm + ((wgid % nig) % gsz); u.pn = (wgid % nig) / gsz; return true;
    }
    __device__ __forceinline__ void a_ready(const Unit&) const {}
    __device__ __forceinline__ void done(const Unit&) const {}
};

__device__ __forceinline__ unsigned cvt_pk_bf16(float lo, float hi) { unsigned r; asm volatile("v_cvt_pk_bf16_f32 %0, %1, %2" : "=v"(r) : "v"(lo), "v"(hi)); return r; }
typedef unsigned u32x4 __attribute__((ext_vector_type(4)));
template <int ACT> struct EpiBf16 {
    static constexpr bool PERM = true, AFTER_DRAIN = false;
    bf16_t* O; int ldc; int scale_cols; float scale0; const unsigned long long* rowss;
    __device__ __forceinline__ void operator()(const f32x4 (&acc)[2][2][4][2], const Unit& u, int wr, int wc, int fr, int fq) const {
        const int row0 = u.pm * BM + wr * 64 + fr; const int colt = u.pn * BM;
        const float sc = (colt < scale_cols) ? scale0 : 1.f;
        const int col0 = colt + wc * 32 + 8 * fq;
#pragma unroll
        for (int ai = 0; ai < 2; ++ai)
#pragma unroll
            for (int m = 0; m < 4; ++m) { bf16_t* rowp = O + (size_t)(row0 + ai * HALF + m * 16) * ldc + col0;
                const float rs = rowss ? sc * (1.0f / sqrtf((float)__hip_atomic_load(rowss + row0 + ai * HALF + m * 16, __ATOMIC_RELAXED, __HIP_MEMORY_SCOPE_AGENT) * (1.0f / (2048.0f * 1048576.0f)) + 1e-6f)) : sc;
#pragma unroll
                for (int bj = 0; bj < 2; ++bj) { f32x4 v0 = acc[ai][bj][m][0] * rs, v1 = acc[ai][bj][m][1] * rs;
                    if (ACT == 1) {
#pragma unroll
                        for (int e = 0; e < 4; ++e) { float a = v0[e] > 0.f ? v0[e] : 0.f; v0[e] = a * a; float b = v1[e] > 0.f ? v1[e] : 0.f; v1[e] = b * b; } }
                    u32x4 w; w.x = cvt_pk_bf16(v0[0], v0[1]); w.y = cvt_pk_bf16(v0[2], v0[3]); w.z = cvt_pk_bf16(v1[0], v1[1]); w.w = cvt_pk_bf16(v1[2], v1[3]);
                    *(u32x4*)(rowp + bj * HALF) = w; } }
    }
};
typedef unsigned u32x2 __attribute__((ext_vector_type(2)));
struct EpiResid {
    static constexpr bool PERM = false, AFTER_DRAIN = false;
    const float* base; float* out; int ldc; const float* gain; bf16_t* xn; unsigned long long* rowss;
    __device__ __forceinline__ void operator()(const f32x4 (&acc)[2][2][4][2], const Unit& u, int wr, int wc, int fr, int fq) const {
        const int col0 = u.pn * BM + wc * 32 + 4 * fq;
        f32x4 cur[2][2], nxt[2][2], gv[2][2];
        const size_t row00 = (size_t)(u.pm * BM + wr * 64 + fr);
#pragma unroll
        for (int bj = 0; bj < 2; ++bj)
#pragma unroll
            for (int n = 0; n < 2; ++n) gv[bj][n] = gain ? *(const f32x4*)(gain + col0 + bj * HALF + n * 16) : (f32x4){0.f, 0.f, 0.f, 0.f};
#pragma unroll
        for (int bj = 0; bj < 2; ++bj)
#pragma unroll
            for (int n = 0; n < 2; ++n) cur[bj][n] = *(const f32x4*)(base + row00 * ldc + col0 + bj * HALF + n * 16);
#pragma unroll
        for (int g8 = 0; g8 < 8; ++g8) { const int ai = g8 >> 2, m = g8 & 3;
            const int row = u.pm * BM + ai * HALF + wr * 64 + m * 16 + fr; const size_t off = (size_t)row * ldc + col0; float ss = 0.f;
            if (g8 < 7) { const int ai2 = (g8 + 1) >> 2, m2 = (g8 + 1) & 3; const size_t off2 = (size_t)(u.pm * BM + ai2 * HALF + wr * 64 + m2 * 16 + fr) * ldc + col0;
#pragma unroll
                for (int bj = 0; bj < 2; ++bj)
#pragma unroll
                    for (int n = 0; n < 2; ++n) nxt[bj][n] = *(const f32x4*)(base + off2 + bj * HALF + n * 16); }
#pragma unroll
            for (int bj = 0; bj < 2; ++bj)
#pragma unroll
                for (int n = 0; n < 2; ++n) { const f32x4 v = cur[bj][n] + acc[ai][bj][m][n]; *(f32x4*)(out + off + bj * HALF + n * 16) = v;
                    if (gain) { ss += (v[0] * v[0] + v[1] * v[1]) + (v[2] * v[2] + v[3] * v[3]); const f32x4 g = gv[bj][n];
                        u32x2 w; w.x = cvt_pk_bf16(v[0] * g[0], v[1] * g[1]); w.y = cvt_pk_bf16(v[2] * g[2], v[3] * g[3]); *(u32x2*)(xn + off + bj * HALF + n * 16) = w; } }
            if (gain) { ss += __shfl_xor(ss, 16); ss += __shfl_xor(ss, 32); if (fq == 0) __hip_atomic_fetch_add(rowss + row, (unsigned long long)(ss * 1048576.0f), __ATOMIC_RELAXED, __HIP_MEMORY_SCOPE_AGENT); }
#pragma unroll
            for (int bj = 0; bj < 2; ++bj)
#pragma unroll
                for (int n = 0; n < 2; ++n) cur[bj][n] = nxt[bj][n];
        }
    }
};
template <class Epi, class Sched, bool ALIGN_EPI = false, bool SP2 = false>
__device__ __forceinline__ void gemm_phase(PG8_LAS unsigned char* lds, const Gemm g, const Sched& S, const Epi& E, const int wid_in) {
    int tid_ = (wid_in << 6) | __builtin_amdgcn_mbcnt_hi(~0u, __builtin_amdgcn_mbcnt_lo(~0u, 0u)); asm volatile("" : "+v"(tid_)); const int tid = tid_, wid = __builtin_amdgcn_readfirstlane(tid >> 6), lane = tid & 63, wr = wid >> 2, wc = wid & 3, fr = lane & 15, fq = lane >> 4;
    const int K = g.K, nt = K / BK;
    unsigned voffA[2], voffB[2];
#pragma unroll
    for (int i = 0; i < 2; ++i) { int R, C; stage_rc(tid * 16 + i * 8192, R, C); const int Rb = Epi::PERM ? ((R & ~31) + perm32(R & 31)) : R;
        voffA[i] = (unsigned)(R * K + C) * 2u; voffB[i] = (unsigned)(Rb * K + C) * 2u; }
    const size_t kstep = (size_t)(BK * 2);
    const size_t hstep = (size_t)HALF * K * 2;
    const size_t tstep = 2 * hstep;
    const unsigned ldsw = (unsigned)wid * 1024u;
    const int aoff = lds_byte(wr * 64 + fr, fq * 8), boff = lds_byte(wc * 32 + fr, fq * 8);
#define PG8_SA(b, h) (((b) * 2 + (h)) * HTB)
#define PG8_SB(b, h) ((4 + (b) * 2 + (h)) * HTB)
#define PG8_STAGE(bufoff, gbase, voff) do { _Pragma("unroll") for (int _i = 0; _i < 2; ++_i) \
        __builtin_amdgcn_global_load_lds((const unsigned*)((const char*)(gbase) + (voff)[_i]), (PG8_LAS unsigned*)(lds + (bufoff) + ldsw + _i * 8192), 16, 0, 0); } while (0)
#define PG8_LDA(dst, b, h) do { _Pragma("unroll") for (int m = 0; m < 4; ++m) _Pragma("unroll") for (int k = 0; k < 2; ++k) dst[m][k] = *(const PG8_LAS bf16x8*)(lds + PG8_SA(b, h) + aoff + m * 2048 + k * 1024); } while (0)
#define PG8_LDB(dst, b, h) do { _Pragma("unroll") for (int n = 0; n < 2; ++n) _Pragma("unroll") for (int k = 0; k < 2; ++k) dst[n][k] = *(const PG8_LAS bf16x8*)(lds + PG8_SB(b, h) + boff + n * 2048 + k * 1024); } while (0)
#define PG8_MMA(ai, bj, At, Bt) do { __builtin_amdgcn_s_setprio(1); _Pragma("unroll") for (int m = 0; m < 4; ++m) _Pragma("unroll") for (int n = 0; n < 2; ++n) _Pragma("unroll") for (int k = 0; k < 2; ++k) \
        acc[ai][bj][m][n] = __builtin_amdgcn_mfma_f32_16x16x32_bf16(Bt[n][k], At[m][k], acc[ai][bj][m][n], 0, 0, 0); __builtin_amdgcn_s_setprio(0); } while (0)
#define PG8_WAIT_V(n) asm volatile("s_waitcnt vmcnt(" #n ")" ::: "memory")
#define PG8_WAIT_L(n) asm volatile("s_waitcnt lgkmcnt(" #n ")" ::: "memory")
#define PG8_BAR __builtin_amdgcn_s_barrier()
#define PG8_SCHED __builtin_amdgcn_sched_barrier(0)
    Unit cur, nxt; int ui = 0;
    if (!S.next(0, cur)) return;
    f32x4 acc[2][2][4][2];
#pragma unroll
    for (int a = 0; a < 2; ++a)
#pragma unroll
        for (int b = 0; b < 2; ++b)
#pragma unroll
            for (int m = 0; m < 4; ++m)
#pragma unroll
                for (int n = 0; n < 2; ++n) acc[a][b][m][n] = (f32x4){0.f, 0.f, 0.f, 0.f};
    bf16x8 At[4][2], B0[2][2], B1[2][2];
    const char* cA = (const char*)g.A + (size_t)cur.pm * tstep; const char* cB = (const char*)g.Bt + (size_t)cur.pn * tstep;
    S.a_ready(cur);
    if constexpr (SP2) {
        PG8_STAGE(PG8_SB(0, 0), cB, voffB); PG8_STAGE(PG8_SB(0, 1), cB + hstep, voffB); PG8_STAGE(PG8_SA(0, 0), cA, voffA); PG8_STAGE(PG8_SA(0, 1), cA + hstep, voffA);
        if (wr == 1) PG8_BAR;
        PG8_WAIT_V(2); PG8_BAR;
        PG8_STAGE(PG8_SB(1, 0), cB + kstep, voffB); PG8_STAGE(PG8_SA(1, 0), cA + kstep, voffA); PG8_STAGE(PG8_SB(1, 1), cB + hstep + kstep, voffB);
        PG8_WAIT_V(6); PG8_BAR;
    } else {
        PG8_STAGE(PG8_SB(0, 0), cB, voffB); PG8_STAGE(PG8_SA(0, 0), cA, voffA); PG8_STAGE(PG8_SB(0, 1), cB + hstep, voffB); PG8_STAGE(PG8_SA(0, 1), cA + hstep, voffA);
        if (wr == 1) PG8_BAR;
        PG8_WAIT_V(4); PG8_BAR;
        PG8_STAGE(PG8_SB(1, 0), cB + kstep, voffB); PG8_STAGE(PG8_SA(1, 0), cA + kstep, voffA); PG8_STAGE(PG8_SB(1, 1), cB + hstep + kstep, voffB);
        PG8_WAIT_V(6); PG8_BAR;
    }
    for (;;) {
        const bool has_next = S.next(ui + 1, nxt);
        const char* nA = has_next ? (const char*)g.A + (size_t)nxt.pm * tstep : cA; const char* nB = has_next ? (const char*)g.Bt + (size_t)nxt.pn * tstep : cB;
        for (int t = 0; t < nt; t += 2) {
            const bool last = (t == nt - 2);
            const char* a1 = cA + (size_t)(t + 1) * kstep;
            const char* a2 = last ? nA : cA + (size_t)(t + 2) * kstep; const char* b2 = last ? nB : cB + (size_t)(t + 2) * kstep;
            const char* a3 = a2 + kstep; const char* b3 = b2 + kstep;
            if (last && has_next) S.a_ready(nxt);
            if constexpr (SP2) {
            PG8_LDB(B0, 0, 0); PG8_LDB(B1, 0, 1); PG8_SCHED; PG8_LDA(At, 0, 0); PG8_STAGE(PG8_SA(1, 1), a1 + hstep, voffA);
            PG8_WAIT_V(8); PG8_WAIT_L(0); PG8_BAR; PG8_MMA(0, 0, At, B0); PG8_MMA(0, 1, At, B1); PG8_BAR; PG8_SCHED;
            PG8_LDA(At, 0, 1); PG8_STAGE(PG8_SB(0, 0), b2, voffB); PG8_STAGE(PG8_SB(0, 1), b2 + hstep, voffB); PG8_STAGE(PG8_SA(0, 0), a2, voffA);
            PG8_WAIT_V(8); PG8_WAIT_L(0); PG8_BAR; PG8_MMA(1, 0, At, B0); PG8_MMA(1, 1, At, B1); PG8_BAR; PG8_SCHED;
            PG8_LDB(B0, 1, 0); PG8_LDB(B1, 1, 1); PG8_SCHED; PG8_LDA(At, 1, 0); PG8_STAGE(PG8_SA(0, 1), a2 + hstep, voffA);
            PG8_WAIT_V(8); PG8_WAIT_L(0); PG8_BAR; PG8_MMA(0, 0, At, B0); PG8_MMA(0, 1, At, B1); PG8_BAR; PG8_SCHED;
            PG8_LDA(At, 1, 1); PG8_STAGE(PG8_SB(1, 0), b3, voffB); PG8_STAGE(PG8_SB(1, 1), b3 + hstep, voffB); PG8_STAGE(PG8_SA(1, 0), a3, voffA);
            PG8_WAIT_V(8); PG8_WAIT_L(0); PG8_BAR; PG8_MMA(1, 0, At, B0); PG8_MMA(1, 1, At, B1); PG8_BAR; PG8_SCHED;
            } else {
            PG8_LDB(B0, 0, 0); PG8_SCHED; PG8_LDA(At, 0, 0); PG8_STAGE(PG8_SA(1, 1), a1 + hstep, voffA);
            PG8_WAIT_L(8); PG8_BAR; PG8_WAIT_L(0); PG8_MMA(0, 0, At, B0); PG8_BAR; PG8_SCHED;
            PG8_LDB(B1, 0, 1); PG8_STAGE(PG8_SB(0, 0), b2, voffB);
            PG8_BAR; PG8_WAIT_L(0); PG8_MMA(0, 1, At, B1); PG8_BAR;
            PG8_LDA(At, 0, 1); PG8_STAGE(PG8_SA(0, 0), a2, voffA);
            PG8_BAR; PG8_WAIT_L(0); PG8_MMA(1, 0, At, B0); PG8_BAR; PG8_SCHED;
            PG8_STAGE(PG8_SB(0, 1), b2 + hstep, voffB);
            PG8_WAIT_V(6); PG8_BAR; PG8_MMA(1, 1, At, B1); PG8_BAR;
            PG8_LDB(B0, 1, 0); PG8_SCHED; PG8_LDA(At, 1, 0); PG8_STAGE(PG8_SA(0, 1), a2 + hstep, voffA);
            PG8_WAIT_L(8); PG8_BAR; PG8_WAIT_L(0); PG8_MMA(0, 0, At, B0); PG8_BAR; PG8_SCHED;
            PG8_LDB(B1, 1, 1); PG8_STAGE(PG8_SB(1, 0), b3, voffB);
            PG8_BAR; PG8_WAIT_L(0); PG8_MMA(0, 1, At, B1); PG8_BAR;
            PG8_LDA(At, 1, 1); PG8_STAGE(PG8_SA(1, 0), a3, voffA);
            PG8_BAR; PG8_WAIT_L(0); PG8_MMA(1, 0, At, B0); PG8_BAR; PG8_SCHED;
            PG8_STAGE(PG8_SB(1, 1), b3 + hstep, voffB);
            PG8_WAIT_V(6); PG8_BAR; PG8_MMA(1, 1, At, B1); PG8_BAR;
            }
        }
        if constexpr (ALIGN_EPI) { if (wr == 0) PG8_BAR; }
        if constexpr (!Epi::AFTER_DRAIN) { E(acc, cur, wr, wc, fr, fq); S.done(cur); }
        if (!has_next) break;
#pragma unroll
        for (int a = 0; a < 2; ++a)
#pragma unroll
            for (int b = 0; b < 2; ++b)
#pragma unroll
                for (int m = 0; m < 4; ++m)
#pragma unroll
                    for (int n = 0; n < 2; ++n) acc[a][b][m][n] = (f32x4){0.f, 0.f, 0.f, 0.f};
        cur = nxt; cA = nA; cB = nB; ++ui;
        if constexpr (ALIGN_EPI) { if (wr == 1) PG8_BAR; }
    }
    PG8_WAIT_V(0);
    if constexpr (!ALIGN_EPI) { if (wr == 0) PG8_BAR; }
    PG8_BAR;
    if constexpr (Epi::AFTER_DRAIN) { E.fused(acc, cur, wr, wc, fr, fq, lds, wid, lane); S.done(cur); }
#undef PG8_SA
#undef PG8_SB
#undef PG8_STAGE
#undef PG8_LDA
#undef PG8_LDB
#undef PG8_MMA
#undef PG8_WAIT_V
#undef PG8_WAIT_L
#undef PG8_BAR
#undef PG8_SCHED
}
}

#ifndef REP_SEL
#define REP_SEL 1
#endif
#ifndef REP_IDXM
#define REP_IDXM 1
#endif
#ifndef REP_UP
#define REP_UP 1
#endif
#ifndef REP_PRO
#define REP_PRO 1
#endif
#ifndef REP_SYNC
#define REP_SYNC 1
#endif
#ifndef REP_SB
#define REP_SB 1
#endif
#ifndef REP_IDX
#define REP_IDX 1
#endif
#ifndef REP_DSA
#define REP_DSA 1
#endif
constexpr int NBATCH = 4, SEQ = 4096, M = NBATCH * SEQ, D = 2048, FF = 8192, DEPTH = 4;
constexpr int NAIN = 6144;
constexpr int NBIN = 4176, NBP = 4352;
constexpr int CQ = 0, CK = 2048, CV = 2560, CQI = 3072, CKI = 4096, CWI = 4160;
constexpr float RMS_EPS = 1e-6f;
constexpr float LOG2E = 1.4426950408889634f;
constexpr float C2 = 0.08838834764831845f * LOG2E;
constexpr int NWAVES = 8;

constexpr size_t MiB = 1u << 20;
constexpr size_t WS_RSS = 963 * MiB;
constexpr size_t WS_WINA = 1 * MiB;
constexpr size_t WS_WOUTA = 49 * MiB;
constexpr size_t WS_WINB = 65 * MiB;
constexpr size_t WS_WOUTB = 99 * MiB;
constexpr size_t WS_WUP = 115 * MiB;
constexpr size_t WS_WDOWN = 243 * MiB;
constexpr size_t WS_XN = 371 * MiB;
constexpr size_t WS_SEL = 435 * MiB;
constexpr size_t WS_SC = 451 * MiB;
constexpr size_t WS_QKV = 707 * MiB;
constexpr size_t WS_AO = 899 * MiB;
constexpr size_t WS_HB = 707 * MiB;
constexpr size_t WS_END = 964 * MiB;

constexpr int LDS_BYTES = 147456;
constexpr int WLDS = 18432;

#define LAS __attribute__((address_space(3)))
typedef unsigned short bf16;
typedef short bf16x8 __attribute__((ext_vector_type(8)));
typedef short s16x4 __attribute__((ext_vector_type(4)));
typedef float f32x4 __attribute__((ext_vector_type(4)));
typedef float f32x2 __attribute__((ext_vector_type(2)));
typedef float f32x16 __attribute__((ext_vector_type(16)));
typedef unsigned u32x4 __attribute__((ext_vector_type(4)));
typedef unsigned u32x2 __attribute__((ext_vector_type(2)));

__device__ __forceinline__ unsigned pk2(float lo, float hi) { return pg8::cvt_pk_bf16(lo, hi); }
__device__ __forceinline__ float bflo(unsigned w) { return __builtin_bit_cast(float, w << 16); }
__device__ __forceinline__ float bfhi(unsigned w) { return __builtin_bit_cast(float, w & 0xffff0000u); }
__device__ __forceinline__ float wave_sum(float v) {
#pragma unroll
    for (int o = 1; o < 64; o <<= 1) v += __shfl_xor(v, o);
    return v;
}
#define LDS_WAIT() asm volatile("s_waitcnt lgkmcnt(0)" ::: "memory")

struct TItem { const float* W; bf16* WT; int K, N, k0, n0; };
__device__ __forceinline__ void titem_load(const TItem& t, int lane, float (&tv)[32]) {
    const int n = t.n0 + (lane & 31); const float* wp = t.W + (size_t)(t.k0 + (lane >> 5)) * t.N + (n < t.N ? n : 0);
#pragma unroll
    for (int i = 0; i < 32; ++i) tv[i] = wp[(size_t)(2 * i) * t.N];
}
__device__ __forceinline__ void titem_to_lds(const TItem& t, int lane, const float (&tv)[32], LAS float* scr) {
    const bool ok = (t.n0 + (lane & 31)) < t.N;
#pragma unroll
    for (int i = 0; i < 32; ++i) { const int kk = 2 * i + (lane >> 5); scr[kk * 33 + (lane & 31)] = ok ? tv[i] : 0.f; }
}
__device__ __forceinline__ void titem_store(const TItem& t, int lane, const LAS float* scr) {
    const int c = lane & 7;
#pragma unroll
    for (int j = 0; j < 4; ++j) { const int nn = (lane >> 3) + 8 * j; const LAS float* s = scr + (8 * c) * 33 + nn;
        u32x4 o; o.x = pk2(s[0 * 33], s[1 * 33]); o.y = pk2(s[2 * 33], s[3 * 33]); o.z = pk2(s[4 * 33], s[5 * 33]); o.w = pk2(s[6 * 33], s[7 * 33]);
        *(u32x4*)(t.WT + (size_t)(t.n0 + nn) * t.K + t.k0 + 8 * c) = o; }
}
__device__ __forceinline__ void rms_row(const float* xrow, const float* g, bf16* orow, int lane) {
    const f32x4* xr = (const f32x4*)xrow + lane; const f32x4* gr = (const f32x4*)g + lane;
    f32x4 v[8]; float s = 0.f;
#pragma unroll
    for (int j = 0; j < 8; ++j) { v[j] = xr[64 * j]; s += (v[j].x * v[j].x + v[j].y * v[j].y) + (v[j].z * v[j].z + v[j].w * v[j].w); }
    const float rstd = 1.0f / sqrtf(wave_sum(s) * (1.f / D) + RMS_EPS);
    u32x2* o8 = (u32x2*)orow + lane;
#pragma unroll
    for (int j = 0; j < 8; ++j) { const f32x4 gg = gr[64 * j]; u32x2 w; w.x = pk2(v[j].x * rstd * gg.x, v[j].y * rstd * gg.y); w.y = pk2(v[j].z * rstd * gg.z, v[j].w * rstd * gg.w); o8[64 * j] = w; }
}
__device__ __forceinline__ void norm_phase(const float* x, const float* g, bf16* xn, int gw, int ngw, int lane) {
    for (int m = gw; m < M; m += ngw) rms_row(x + (size_t)m * D, g, xn + (size_t)m * D, lane);
}

__device__ __forceinline__ s16x4 vtr(const LAS unsigned char* p) { return __builtin_bit_cast(s16x4, __builtin_amdgcn_ds_read_tr16_b64_v4i16((LAS s16x4*)p)); }
__device__ __forceinline__ float softplus2(float z2) {
    const float e = __builtin_amdgcn_exp2f(-__builtin_fabsf(z2));
    return __builtin_fmaxf(z2, 0.f) + __builtin_amdgcn_logf(1.0f + e);
}
__device__ __forceinline__ void sb_unit(const bf16* QKV, bf16* AO, int b, int h, int qblk, LAS unsigned char* wl, int lane) {
    const int qi = lane & 31, hi = lane >> 5;
    const int t0 = qblk * 32, t = t0 + qi;
    const size_t rowbase = (size_t)b * SEQ;
    bf16x8 qf[8];
    { const bf16* qp = QKV + (rowbase + t0 + qi) * NAIN + h * 128 + 8 * hi;
#pragma unroll
      for (int ks = 0; ks < 8; ++ks) qf[ks] = *(const bf16x8*)(qp + 16 * ks); }
    f32x16 o[4];
#pragma unroll
    for (int c = 0; c < 4; ++c)
#pragma unroll
        for (int r = 0; r < 16; ++r) o[c][r] = 0.f;
    float C = 0.f;
    const int km = 16 * (qi >> 4) + 8 * ((qi >> 2) & 1) + 4 * ((qi >> 3) & 1) + (qi & 3);
    const int trow = 8 * hi + ((lane & 15) >> 2), tcol = 16 * ((lane >> 4) & 1) + 4 * (lane & 3);
    const LAS unsigned char* vbase = wl + trow * 288 + tcol * 2;
    const int ktop = qblk;
    for (int kt = ktop; kt >= 0; --kt) {
        const int k0 = kt * 32;
        { const bf16* vp = QKV + (rowbase + k0 + (lane >> 4)) * NAIN + 2 * D + h * 128 + (lane & 15) * 8;
          LAS unsigned char* dst = wl + (lane >> 4) * 288 + (lane & 15) * 16;
          LAS unsigned char* kdst = wl + 9216 + (lane >> 4) * 272 + (lane & 15) * 16;
          bf16x8 tmp[8], tk[8];
#pragma unroll
          for (int i = 0; i < 8; ++i) tk[i] = *(const bf16x8*)(vp - D + (size_t)(4 * i) * NAIN);
#pragma unroll
          for (int i = 0; i < 8; ++i) tmp[i] = *(const bf16x8*)(vp + (size_t)(4 * i) * NAIN);
#pragma unroll
          for (int i = 0; i < 8; ++i) *(LAS bf16x8*)(kdst + (4 * i) * 272) = tk[i];
#pragma unroll
          for (int i = 0; i < 8; ++i) *(LAS bf16x8*)(dst + (4 * i) * 288) = tmp[i];
        }
        asm volatile("" ::: "memory");
        f32x16 p0;
#pragma unroll
        for (int r = 0; r < 16; ++r) p0[r] = 0.f;
        { const LAS unsigned char* kf = wl + 9216 + km * 272 + 16 * hi;
          LDS_WAIT();
#pragma unroll
          for (int ks = 0; ks < 8; ++ks) { const bf16x8 a0 = *(const LAS bf16x8*)(kf + 32 * ks); p0 = __builtin_amdgcn_mfma_f32_32x32x16_bf16(a0, qf[ks], p0, 0, 0, 0); } }
        f32x16 s0;
#pragma unroll
        for (int r = 0; r < 16; ++r) s0[r] = softplus2(p0[r]);
        if (kt == ktop) {
#pragma unroll
            for (int r = 0; r < 16; ++r) { const int key0 = k0 + 16 * (r >> 3) + 8 * hi + (r & 7);
                if (key0 >= t) { s0[r] = 0.f; p0[r] = -__builtin_inff(); } }
        }
        float T0 = 0.f, T1 = 0.f;
#pragma unroll
        for (int r = 0; r < 8; ++r) { T0 += s0[r]; T1 += s0[8 + r]; }
        const float U0 = __shfl_xor(T0, 32), U1 = __shfl_xor(T1, 32);
        const float b1 = C, b0 = b1 + T1 + U1;
        const float Cn = b0 + T0 + U0;
        float run1 = b1 + (hi ? 0.f : U1), run0 = b0 + (hi ? 0.f : U0);
#pragma unroll
        for (int r = 7; r >= 0; --r) {
            run1 += s0[8 + r]; p0[8 + r] = __builtin_amdgcn_exp2f(p0[8 + r] - run1);
            run0 += s0[r];     p0[r]     = __builtin_amdgcn_exp2f(p0[r] - run0);
        }
        C = Cn;
        bf16x8 pf[2];
        { u32x4 w;
          w.x = pk2(p0[0], p0[1]); w.y = pk2(p0[2], p0[3]); w.z = pk2(p0[4], p0[5]); w.w = pk2(p0[6], p0[7]); pf[0] = __builtin_bit_cast(bf16x8, w);
          w.x = pk2(p0[8], p0[9]); w.y = pk2(p0[10], p0[11]); w.z = pk2(p0[12], p0[13]); w.w = pk2(p0[14], p0[15]); pf[1] = __builtin_bit_cast(bf16x8, w); }
        LDS_WAIT();
#pragma unroll
        for (int c = 0; c < 4; ++c)
#pragma unroll
            for (int ks = 0; ks < 2; ++ks) {
                const s16x4 lo = vtr(vbase + (16 * ks) * 288 + c * 64), hh = vtr(vbase + (16 * ks + 4) * 288 + c * 64);
                const bf16x8 vf = (bf16x8){lo[0], lo[1], lo[2], lo[3], hh[0], hh[1], hh[2], hh[3]};
                o[c] = __builtin_amdgcn_mfma_f32_32x32x16_bf16(pf[ks], vf, o[c], 0, 0, 0);
            }
        LDS_WAIT();
        if (__all(C >= 151.0f)) break;
    }
    bf16* op = AO + (rowbase + t0) * D + h * 128 + (lane & 31);
#pragma unroll
    for (int c = 0; c < 4; ++c)
#pragma unroll
        for (int r = 0; r < 16; ++r) { const int row = (r & 3) + 8 * (r >> 2) + 4 * hi; op[(size_t)row * D + 32 * c] = (bf16)(pk2(o[c][r], 0.f) & 0xffffu); }
}

__device__ __forceinline__ unsigned fkey(float f) { const unsigned u = __builtin_bit_cast(unsigned, f); return (u & 0x80000000u) ? ~u : (u | 0x80000000u); }
__device__ __forceinline__ int mbcnt(unsigned long long m) { return __builtin_amdgcn_mbcnt_hi((unsigned)(m >> 32), __builtin_amdgcn_mbcnt_lo((unsigned)m, 0u)); }

#define PIN8(m) asm volatile("" : "+s"(m[0]), "+s"(m[1]), "+s"(m[2]), "+s"(m[3]), "+s"(m[4]), "+s"(m[5]), "+s"(m[6]), "+s"(m[7]))
__device__ __forceinline__ void select_query(const float* sc, int* sel, int ce, int lane) {
    const int nreg = ce >> 6;
    unsigned key[64];
    {
        float raw[64];
#pragma unroll
        for (int g = 0; g < 8; ++g) {
            if (8 * g + 8 <= nreg) {
#pragma unroll
                for (int j = 8 * g; j < 8 * g + 8; ++j) raw[j] = sc[lane + 64 * j];
            } else if (8 * g < nreg) {
#pragma unroll
                for (int j = 8 * g; j < 8 * g + 4; ++j) raw[j] = sc[lane + 64 * j];
                if (8 * g + 4 < nreg) {
#pragma unroll
                    for (int j = 8 * g + 4; j < 8 * g + 8; ++j) raw[j] = sc[lane + 64 * j];
                } else {
#pragma unroll
                    for (int j = 8 * g + 4; j < 8 * g + 8; ++j) raw[j] = 0.f;
                }
            } else {
#pragma unroll
                for (int j = 8 * g; j < 8 * g + 8; ++j) raw[j] = 0.f;
            }
        }
#pragma unroll
        for (int j = 0; j < 64; ++j) key[j] = (j < nreg) ? fkey(raw[j]) : 0u;
    }
    unsigned prefix = 0u; bool exact = false;
    for (int bit = 31; bit >= 0; --bit) {
        const unsigned cand = prefix | (1u << bit);
        int cnt = 0;
#pragma unroll
        for (int g = 0; g < 8; ++g) if (8 * g < nreg) {
            unsigned long long m[8];
#pragma unroll
            for (int j = 0; j < 8; ++j) m[j] = __ballot(key[8 * g + j] >= cand);
            PIN8(m);
#pragma unroll
            for (int j = 0; j < 8; ++j) cnt += __builtin_popcountll(m[j]);
            asm volatile("" : "+s"(cnt));
        }
        if (cnt >= 256) prefix = cand;
        if (cnt == 256) { exact = true; break; }
    }
    const unsigned thr = exact ? prefix - 1u : prefix;
    int pos = 0;
#pragma unroll
    for (int g = 0; g < 8; ++g) if (8 * g < nreg) {
        unsigned long long m[8];
#pragma unroll
        for (int j = 0; j < 8; ++j) m[j] = __ballot(key[8 * g + j] > thr);
        PIN8(m);
#pragma unroll
        for (int j = 0; j < 8; ++j) { if (key[8 * g + j] > thr) sel[pos + mbcnt(m[j])] = lane + 64 * (8 * g + j); pos += __builtin_popcountll(m[j]); }
        asm volatile("" : "+s"(pos));
    }
    int need = 256 - pos;
    if (need > 0)
#pragma unroll
    for (int g = 0; g < 8; ++g) if (8 * g < nreg) {
        unsigned long long m[8];
#pragma unroll
        for (int j = 0; j < 8; ++j) m[j] = __ballot(key[8 * g + j] == prefix);
        PIN8(m);
#pragma unroll
        for (int j = 0; j < 8; ++j) { const int rank = mbcnt(m[j]);
            if (key[8 * g + j] == prefix && rank < need) sel[pos + rank] = lane + 64 * (8 * g + j);
            const int c = __builtin_popcountll(m[j]); const int take = c < need ? c : need; pos += take; need -= take; }
        asm volatile("" : "+s"(pos), "+s"(need));
    }
}

__device__ __forceinline__ void idx_unit(bf16* QB, float* SC, int* SEL, const float* qg, const float* kg, int b, int tp, LAS unsigned char* wl, int lane, bool do_norm) {
    const int t = 4 * tp; const size_t rowbase = (size_t)b * SEQ; const size_t row = rowbase + t;
    const int n = lane & 31, hi = lane >> 5;
    const int ce = ((t >> 6) + 1) << 6;
    if (ce > 256) {
        bf16x8 af[2][4];
#pragma unroll
        for (int q2 = 0; q2 < 2; ++q2) { const bf16* ap = QB + (row + 2 * q2 + (n >> 4)) * NBP + CQI + (n & 15) * 64 + 8 * hi;
#pragma unroll
          for (int ks = 0; ks < 4; ++ks) af[q2][ks] = *(const bf16x8*)(ap + 16 * ks); }
        float w[4][8];
#pragma unroll
        for (int a = 0; a < 4; ++a)
#pragma unroll
            for (int r = 0; r < 8; ++r) { const int hh = (r & 3) + 8 * (r >> 2) + 4 * hi; w[a][r] = 0.25f * bflo((unsigned)QB[(row + a) * NBP + CWI + hh]); }
        float* scw0 = SC + (row + hi) * SEQ + n; float* scw1 = scw0 + 2 * (size_t)SEQ;
        const int r8 = lane >> 3, c8 = lane & 7;
        const bf16* kg8 = QB + (rowbase + r8) * NBP + CKI + c8 * 8;
        LAS unsigned char* sdst = wl + r8 * 144 + c8 * 16;
        const LAS unsigned char* fsrc = wl + n * 144 + 16 * hi;
        bf16x8 cur[8];
#pragma unroll
        for (int i = 0; i < 8; ++i) cur[i] = *(const bf16x8*)(kg8 + (size_t)(8 * i) * NBP);
        for (int s0 = 0; s0 < ce; s0 += 64) {
#pragma unroll
            for (int i = 0; i < 8; ++i) *(LAS bf16x8*)(sdst + (8 * i) * 144) = cur[i];
            const int sn = (s0 + 64 < ce) ? s0 + 64 : 0;
#pragma unroll
            for (int i = 0; i < 8; ++i) cur[i] = *(const bf16x8*)(kg8 + (size_t)(sn + 8 * i) * NBP);
            LDS_WAIT();
#pragma unroll
            for (int tt = 0; tt < 2; ++tt) {
                f32x16 acc0, acc1;
#pragma unroll
                for (int r = 0; r < 16; ++r) { acc0[r] = 0.f; acc1[r] = 0.f; }
#pragma unroll
                for (int ks = 0; ks < 4; ++ks) { const bf16x8 bfr = *(const LAS bf16x8*)(fsrc + tt * 32 * 144 + 32 * ks);
                    acc0 = __builtin_amdgcn_mfma_f32_32x32x16_bf16(af[0][ks], bfr, acc0, 0, 0, 0); acc1 = __builtin_amdgcn_mfma_f32_32x32x16_bf16(af[1][ks], bfr, acc1, 0, 0, 0); }
                float pa = 0.f, pb = 0.f, pc = 0.f, pd = 0.f;
#pragma unroll
                for (int r = 0; r < 8; ++r) { pa += w[0][r] * (__builtin_fmaxf(acc0[r], 0.f) * 0.125f); pb += w[1][r] * (__builtin_fmaxf(acc0[8 + r], 0.f) * 0.125f);
                                              pc += w[2][r] * (__builtin_fmaxf(acc1[r], 0.f) * 0.125f); pd += w[3][r] * (__builtin_fmaxf(acc1[8 + r], 0.f) * 0.125f); }
                const float snd0 = hi ? pa : pb, snd1 = hi ? pc : pd; const float rcv0 = __shfl_xor(snd0, 32), rcv1 = __shfl_xor(snd1, 32);
                scw0[s0 + 32 * tt] = (hi ? pb : pa) + rcv0;
                scw1[s0 + 32 * tt] = (hi ? pd : pc) + rcv1;
            }
            LDS_WAIT();
        }
        __builtin_amdgcn_fence(__ATOMIC_SEQ_CST, "workgroup");
        asm volatile("s_waitcnt vmcnt(0)" ::: "memory");
#pragma unroll 1
        for (int a = 0; a < 4; ++a) select_query(SC + (row + a) * SEQ, SEL + (row + a) * 256, ce, lane);
    } else {
#pragma unroll
        for (int i = 0; i < 4; ++i) { const int p = lane + 64 * i; if (p < ce) {
#pragma unroll
            for (int a = 0; a < 4; ++a) SEL[(row + a) * 256 + p] = p; } }
    }
    if (!do_norm) return;
    const int lg = lane >> 4, li = lane & 15;
#pragma unroll 1
    for (int a = 0; a < 4; ++a)
#pragma unroll 1
        for (int p = 0; p < 5; ++p) {
            const int col = (p < 4) ? (CQ + (4 * p + lg) * 128) : (CK + lg * 128);
            bf16* ptr = QB + (row + a) * NBP + col + 8 * li;
            const u32x4 w = *(const u32x4*)ptr;
            float v[8] = {bflo(w.x), bfhi(w.x), bflo(w.y), bfhi(w.y), bflo(w.z), bfhi(w.z), bflo(w.w), bfhi(w.w)};
            float s = 0.f;
#pragma unroll
            for (int e = 0; e < 8; ++e) s += v[e] * v[e];
            s += __shfl_xor(s, 1); s += __shfl_xor(s, 2); s += __shfl_xor(s, 4); s += __shfl_xor(s, 8);
            const float rstd = (1.0f / sqrtf(s * (1.f / 128.f) + RMS_EPS)) * ((p < 4) ? C2 : 1.f);
            const float* gp = ((p < 4) ? qg : kg) + 8 * li;
            const f32x4 g0 = *(const f32x4*)gp, g1 = *(const f32x4*)(gp + 4);
            u32x4 o; o.x = pk2(v[0] * rstd * g0.x, v[1] * rstd * g0.y); o.y = pk2(v[2] * rstd * g0.z, v[3] * rstd * g0.w);
            o.z = pk2(v[4] * rstd * g1.x, v[5] * rstd * g1.y); o.w = pk2(v[6] * rstd * g1.z, v[7] * rstd * g1.w);
            *(u32x4*)ptr = o;
        }
}

__device__ __forceinline__ int t5_bucket(int rel) {
    const int nabs = rel < 0 ? -rel : rel;
    int bk = nabs;
    if (nabs >= 8) bk = 8 + (nabs >= 12) + (nabs >= 16) + (nabs >= 23) + (nabs >= 32) + (nabs >= 46) + (nabs >= 64) + (nabs >= 91);
    return bk + (rel > 0 ? 16 : 0);
}
typedef float f32x4v __attribute__((ext_vector_type(4)));
__device__ __forceinline__ void dsa_unit(const bf16* QB, const int* SEL, bf16* AO, int b, int kvh, int t, LAS unsigned char* wl, int lane) {
    const size_t rowbase = (size_t)b * SEQ, row = rowbase + t;
    const int n = lane & 31, hi = lane >> 5, l15 = lane & 15, kq = lane >> 4;
    const int ce = ((t >> 6) + 1) << 6; const int nsel = ce < 256 ? ce : 256;
    LAS unsigned char* buf = wl;
    LAS bf16* pT = (LAS bf16*)(wl + 9216);
    LAS int* il = (LAS int*)(wl + 11264);
    const LAS float* bl = (const LAS float*)(wl + 12288) + kvh * 128;
    int sidx[8];
#pragma unroll
    for (int kb = 0; kb < 8; ++kb) { const int p = 32 * kb + n; sidx[kb] = (p < nsel) ? SEL[row * 256 + p] : 0; }
    bf16x8 qf[4];
    { const bf16* qp = QB + row * NBP + CQ + (kvh * 4 + (l15 & 3)) * 128 + 8 * kq;
#pragma unroll
      for (int ks = 0; ks < 4; ++ks) qf[ks] = *(const bf16x8*)(qp + 32 * ks); }
    if (hi == 0) {
#pragma unroll
        for (int kb = 0; kb < 8; ++kb) il[32 * kb + n] = sidx[kb];
    }
    LDS_WAIT();
    const int r4 = kq, c16 = l15;
    const bf16* kg = QB + rowbase * NBP + CK + kvh * 128 + c16 * 8;
    const bf16* vg = QB + rowbase * NBP + CV + kvh * 128 + c16 * 8;
    bf16x8 kr[3][8];
#pragma unroll
    for (int pb = 0; pb < 3; ++pb)
#pragma unroll
        for (int i = 0; i < 8; ++i) kr[pb][i] = *(const bf16x8*)(kg + (size_t)il[32 * pb + 4 * i + r4] * NBP);
    float lg[8][4];
    float mx[4] = {-__builtin_inff(), -__builtin_inff(), -__builtin_inff(), -__builtin_inff()};
    LAS unsigned char* kdst = buf + r4 * 272 + c16 * 16;
    const LAS unsigned char* kfb = buf + l15 * 272 + 16 * kq;
    const bool upper = (lane >> 4) & 1;
#pragma unroll
    for (int kb = 0; kb < 8; ++kb) {
#pragma unroll
        for (int i = 0; i < 8; ++i) *(LAS bf16x8*)(kdst + (4 * i) * 272) = kr[kb % 3][i];
        if (kb + 3 < 8) {
#pragma unroll
            for (int i = 0; i < 8; ++i) kr[kb % 3][i] = *(const bf16x8*)(kg + (size_t)il[32 * (kb + 3) + 4 * i + r4] * NBP);
        }
        LDS_WAIT();
        f32x4v a0 = {0.f, 0.f, 0.f, 0.f}, a1 = {0.f, 0.f, 0.f, 0.f};
#pragma unroll
        for (int ks = 0; ks < 4; ++ks) { const bf16x8 b0 = *(const LAS bf16x8*)(kfb + 64 * ks), b1 = *(const LAS bf16x8*)(kfb + 16 * 272 + 64 * ks);
            a0 = __builtin_amdgcn_mfma_f32_16x16x32_bf16(qf[ks], b0, a0, 0, 0, 0); a1 = __builtin_amdgcn_mfma_f32_16x16x32_bf16(qf[ks], b1, a1, 0, 0, 0); }
        LDS_WAIT();
        const int bk = t5_bucket(sidx[kb] - t);
        const bool valid = (32 * kb + n) < nsel;
#pragma unroll
        for (int g = 0; g < 4; ++g) { const float raw = upper ? a1[g] : a0[g]; const float v = valid ? raw + bl[g * 32 + bk] : -__builtin_inff(); lg[kb][g] = v; mx[g] = __builtin_fmaxf(mx[g], v); }
    }
    bf16x8 vr[3][8];
#pragma unroll
    for (int pb = 0; pb < 3; ++pb)
#pragma unroll
        for (int i = 0; i < 8; ++i) vr[pb][i] = *(const bf16x8*)(vg + (size_t)il[32 * pb + 4 * i + r4] * NBP);
#pragma unroll
    for (int g = 0; g < 4; ++g) {
        float m = mx[g];
        m = __builtin_fmaxf(m, __shfl_xor(m, 1)); m = __builtin_fmaxf(m, __shfl_xor(m, 2)); m = __builtin_fmaxf(m, __shfl_xor(m, 4)); m = __builtin_fmaxf(m, __shfl_xor(m, 8)); m = __builtin_fmaxf(m, __shfl_xor(m, 16));
        float s = 0.f;
#pragma unroll
        for (int kb = 0; kb < 8; ++kb) { const float e = __builtin_amdgcn_exp2f(lg[kb][g] - m); lg[kb][g] = e; s += e; }
        s += __shfl_xor(s, 1); s += __shfl_xor(s, 2); s += __shfl_xor(s, 4); s += __shfl_xor(s, 8); s += __shfl_xor(s, 16);
        const float inv = 1.0f / s;
#pragma unroll
        for (int kb = 0; kb < 8; ++kb) if ((kb >> 2) == hi) pT[g * 256 + 32 * kb + n] = (bf16)(pk2(lg[kb][g] * inv, 0.f) & 0xffffu);
    }
    f32x4v o[8];
#pragma unroll
    for (int c = 0; c < 8; ++c) o[c] = (f32x4v){0.f, 0.f, 0.f, 0.f};
    const LAS unsigned char* vtb = buf + (8 * kq + (l15 >> 2)) * 288 + (lane & 3) * 8;
    LAS unsigned char* vdst = buf + r4 * 288 + c16 * 16;
    const LAS bf16* pfp = pT + (l15 & 3) * 256 + 8 * kq;
#pragma unroll
    for (int ch = 0; ch < 8; ++ch) {
#pragma unroll
        for (int i = 0; i < 8; ++i) *(LAS bf16x8*)(vdst + (4 * i) * 288) = vr[ch % 3][i];
        if (ch + 3 < 8) {
#pragma unroll
            for (int i = 0; i < 8; ++i) vr[ch % 3][i] = *(const bf16x8*)(vg + (size_t)il[32 * (ch + 3) + 4 * i + r4] * NBP);
        }
        const bf16x8 pf = *(const LAS bf16x8*)(pfp + 32 * ch);
        LDS_WAIT();
#pragma unroll
        for (int c = 0; c < 8; ++c) {
            const s16x4 lo = vtr(vtb + c * 32), hh = vtr(vtb + 4 * 288 + c * 32);
            o[c] = __builtin_amdgcn_mfma_f32_16x16x32_bf16(pf, (bf16x8){lo[0], lo[1], lo[2], lo[3], hh[0], hh[1], hh[2], hh[3]}, o[c], 0, 0, 0);
        }
        LDS_WAIT();
    }
    bf16* op = AO + row * D + (kvh * 4) * 128 + 16 * kq + l15;
#pragma unroll
    for (int i = 0; i < 2; ++i)
#pragma unroll
        for (int g = 0; g < 4; ++g) {
            const float v = (kq == 0) ? o[4 * i][g] : (kq == 1) ? o[4 * i + 1][g] : (kq == 2) ? o[4 * i + 2][g] : o[4 * i + 3][g];
            op[g * 128 + 64 * i] = (bf16)(pk2(v, 0.f) & 0xffffu);
        }
}

__device__ __forceinline__ void grid_barrier(unsigned* bar, unsigned round) {
    asm volatile("s_waitcnt vmcnt(0) lgkmcnt(0)" ::: "memory");
    __syncthreads();
    if (threadIdx.x == 0) {
        __builtin_amdgcn_fence(__ATOMIC_RELEASE, "agent");
        asm volatile("s_waitcnt vmcnt(0)" ::: "memory");
        const unsigned g = blockIdx.x & 7u, gsz = (gridDim.x - g + 7u) >> 3;
        const unsigned old = __hip_atomic_fetch_add(bar + 64 * (1 + g), 1u, __ATOMIC_RELAXED, __HIP_MEMORY_SCOPE_AGENT);
        if (old + 1u == gsz * round) __hip_atomic_fetch_add(bar, 1u, __ATOMIC_RELAXED, __HIP_MEMORY_SCOPE_AGENT);
        while (__hip_atomic_load(bar, __ATOMIC_RELAXED, __HIP_MEMORY_SCOPE_AGENT) < 8u * round) __builtin_amdgcn_s_sleep(1);
        __builtin_amdgcn_fence(__ATOMIC_ACQUIRE, "agent");
        asm volatile("s_waitcnt vmcnt(0)" ::: "memory");
    }
    __syncthreads();
}

struct Args { const float* in[12]; float* out; unsigned char* ws; int ph_lo, ph_hi; };
enum { I_X = 0, I_NMIX, I_WINA, I_WOUTA, I_WINB, I_WOUTB, I_QN, I_KN, I_RELB, I_NMLP, I_WUP, I_WDOWN };

__global__ void __launch_bounds__(NWAVES * 64, 2) fwd_megakernel(Args args) {
    extern __shared__ __attribute__((aligned(16))) unsigned char lds_raw[];
    LAS unsigned char* lds = (LAS unsigned char*)lds_raw;
    cg::grid_group grid = cg::this_grid();
    const int wave = __builtin_amdgcn_readfirstlane((int)threadIdx.x >> 6);
    const int G = gridDim.x, gw = blockIdx.x * NWAVES + wave, ngw = G * NWAVES;
    LAS unsigned char* wl = lds + wave * WLDS;
    unsigned char* ws = args.ws;
    const float* x_in = args.in[I_X];
    float* xres = args.out;
    bf16* XN = (bf16*)(ws + WS_XN); bf16* QKV = (bf16*)(ws + WS_QKV); bf16* AO = (bf16*)(ws + WS_AO); bf16* HB = (bf16*)(ws + WS_HB);
    int* SEL = (int*)(ws + WS_SEL); float* SC = (float*)(ws + WS_SC);
    const int lo = args.ph_lo, hi = args.ph_hi;
    int ph = 0;
    unsigned* bar_ctr = (unsigned*)ws; unsigned bar_target = 0u;
#define PH_BEGIN if (ph >= lo && ph < hi) { int lane = __builtin_amdgcn_mbcnt_hi(~0u, __builtin_amdgcn_mbcnt_lo(~0u, 0u)); asm volatile("" : "+v"(lane));
#define PH_END if (ph + 1 < hi) { for (int rsy = 0; rsy < REP_SYNC; ++rsy) { if (ph == lo) grid.sync(); else { bar_target += 1u; grid_barrier(bar_ctr, bar_target); } } } } ++ph;

    PH_BEGIN
    {
        LAS float* scr = (LAS float*)wl;
        constexpr int I_A = 32 * (NAIN / 32), I_O = 32 * (D / 32), I_B = 32 * (NBP / 32), I_U = 32 * (FF / 32), I_DN = (FF / 64) * (D / 32);
        constexpr int NITEMS = 2 * I_A + 2 * I_O + 2 * I_B + 2 * I_O + 4 * I_U + 4 * I_DN;
        auto decode = [&](int it) -> TItem {
            int r = it; const float* W; bf16* WT; int K, N, Np, l, q;
            if (r < 2 * I_A) { l = r / I_A; q = r % I_A; W = args.in[I_WINA] + (size_t)l * D * NAIN; WT = (bf16*)(ws + WS_WINA) + (size_t)l * NAIN * D; K = D; N = NAIN; Np = NAIN; }
            else if ((r -= 2 * I_A) < 2 * I_O) { l = r / I_O; q = r % I_O; W = args.in[I_WOUTA] + (size_t)l * D * D; WT = (bf16*)(ws + WS_WOUTA) + (size_t)l * D * D; K = D; N = D; Np = D; }
            else if ((r -= 2 * I_O) < 2 * I_B) { l = r / I_B; q = r % I_B; W = args.in[I_WINB] + (size_t)l * D * NBIN; WT = (bf16*)(ws + WS_WINB) + (size_t)l * NBP * D; K = D; N = NBIN; Np = NBP; }
            else if ((r -= 2 * I_B) < 2 * I_O) { l = r / I_O; q = r % I_O; W = args.in[I_WOUTB] + (size_t)l * D * D; WT = (bf16*)(ws + WS_WOUTB) + (size_t)l * D * D; K = D; N = D; Np = D; }
            else if ((r -= 2 * I_O) < 4 * I_U) { l = r / I_U; q = r % I_U; W = args.in[I_WUP] + (size_t)l * D * FF; WT = (bf16*)(ws + WS_WUP) + (size_t)l * FF * D; K = D; N = FF; Np = FF; }
            else { r -= 4 * I_U; l = r / I_DN; q = r % I_DN; W = args.in[I_WDOWN] + (size_t)l * FF * D; WT = (bf16*)(ws + WS_WDOWN) + (size_t)l * D * FF; K = FF; N = D; Np = D; }
            const int nblk = Np / 32; TItem t; t.W = W; t.WT = WT; t.K = K; t.N = N; t.k0 = 64 * (q / nblk); t.n0 = 32 * (q % nblk); return t; };
        float tv[32];
        if (gw < NITEMS) { const TItem t0 = decode(gw); titem_load(t0, lane, tv); }
        for (int rep = 0; rep < REP_PRO; ++rep)
        for (int it = gw; it < NITEMS; it += ngw) {
            const TItem t = decode(it);
            titem_to_lds(t, lane, tv, scr);
            { const int nx = (it + ngw < NITEMS) ? it + ngw : it; const TItem tn = decode(nx); titem_load(tn, lane, tv); }
            LDS_WAIT();
            titem_store(t, lane, scr);
            LDS_WAIT();
        }
        norm_phase(x_in, args.in[I_NMIX], XN, gw, ngw, lane);
        if (blockIdx.x == 0 && wave == 0 && lane < 9) __hip_atomic_store(bar_ctr + 64 * lane, 0u, __ATOMIC_RELAXED, __HIP_MEMORY_SCOPE_AGENT);
        { unsigned long long* z = (unsigned long long*)(ws + WS_RSS); for (int i = gw * 64 + lane; i < 8 * M; i += ngw * 64) __hip_atomic_store(z + i, 0ull, __ATOMIC_RELAXED, __HIP_MEMORY_SCOPE_AGENT); }
        __syncthreads();
    }
    PH_END

#pragma unroll 1
    for (int L = 0; L < DEPTH; ++L) {
        const int j = L >> 1; const bool isA = (L & 1) == 0;
        const float* xbase = (L == 0) ? x_in : xres;
        unsigned long long* rss_all = (unsigned long long*)(ws + WS_RSS);
        const unsigned long long* rss_mix = (L == 0) ? (const unsigned long long*)nullptr : rss_all + (size_t)(2 * L - 1) * M;
        unsigned long long* rss_mlp = rss_all + (size_t)(2 * L) * M; unsigned long long* rss_next = rss_all + (size_t)(2 * L + 1) * M;
        PH_BEGIN
        if (isA) {
            pg8::Gemm g{XN, (const bf16*)(ws + WS_WINA) + (size_t)j * NAIN * D, M, NAIN, D}; pg8::StaticOrder S; S.init(M, NAIN, G, (int)blockIdx.x);
            pg8::EpiBf16<0> E{QKV, NAIN, D, C2, rss_mix};
            pg8::gemm_phase<pg8::EpiBf16<0>, pg8::StaticOrder, true, true>(lds, g, S, E, wave);
        } else {
            pg8::Gemm g{XN, (const bf16*)(ws + WS_WINB) + (size_t)j * NBP * D, M, NBP, D}; pg8::StaticOrder S; S.init(M, NBP, G, (int)blockIdx.x);
            pg8::EpiBf16<0> E{QKV, NBP, 0, 1.f, rss_mix};
            pg8::gemm_phase<pg8::EpiBf16<0>, pg8::StaticOrder, true, true>(lds, g, S, E, wave);
        }
        PH_END
        if (isA) {
            PH_BEGIN
            for (int rep = 0; rep < REP_SB; ++rep) for (int u = gw; u < NBATCH * 16 * (SEQ / 32); u += ngw) { const int qblk = u % (SEQ / 32), bh = u / (SEQ / 32);
#ifndef NO_SB
 sb_unit(QKV, AO, bh >> 4, bh & 15, qblk, wl, lane);
#endif
 }
            __syncthreads();
            PH_END
        } else {
            PH_BEGIN
            {
                const int per = SEQ / 4;
                for (int rep = 0; rep < REP_IDX; ++rep) for (int i = 0; i * ngw < NBATCH * per; ++i) { const int u = i * ngw + gw; if (u >= NBATCH * per) break;
                    const int bb = u / per; int tp = u % per; if (i & 1) tp = per - 1 - tp;

#ifndef NO_IDX
 idx_unit(QKV, SC, SEL, args.in[I_QN] + j * 128, args.in[I_KN] + j * 128, bb, tp, wl, lane, rep == REP_IDX - 1);
#endif
 }
                __syncthreads();
            }
            PH_END
            PH_BEGIN
            {
                { LAS float* blw = (LAS float*)(wl + 12288);
#pragma unroll
                  for (int i = 0; i < 8; ++i) blw[lane + 64 * i] = LOG2E * args.in[I_RELB][lane + 64 * i];
                  LDS_WAIT(); }
                for (int rep = 0; rep < REP_DSA; ++rep)
                if ((G & 7) == 0) { const int x = blockIdx.x & 7; const int nxw = (G >> 3) * NWAVES; const int wx = (blockIdx.x >> 3) * NWAVES + wave;
                    for (int i = wx; i < 2 * SEQ; i += nxw) { const int combo = x + 8 * (i / SEQ);
#ifndef NO_DSA
 dsa_unit(QKV, SEL, AO, combo >> 2, combo & 3, i % SEQ, wl, lane);
#endif
 } }
                else { for (int i = gw; i < 16 * SEQ; i += ngw) { const int combo = i / SEQ;
#ifndef NO_DSA
 dsa_unit(QKV, SEL, AO, combo >> 2, combo & 3, i % SEQ, wl, lane);
#endif
 } }
                __syncthreads();
            }
            PH_END
        }
        PH_BEGIN
        {
            const bf16* wo = isA ? (const bf16*)(ws + WS_WOUTA) + (size_t)j * D * D : (const bf16*)(ws + WS_WOUTB) + (size_t)j * D * D;
            pg8::Gemm g{AO, wo, M, D, D}; pg8::StaticOrder S; S.init(M, D, G, (int)blockIdx.x);
            pg8::EpiResid E{xbase, xres, D, args.in[I_NMLP] + (size_t)L * D, XN, rss_mlp};
            pg8::gemm_phase<pg8::EpiResid, pg8::StaticOrder, true, true>(lds, g, S, E, wave);
        }
        PH_END
        PH_BEGIN
        {
            pg8::Gemm g{XN, (const bf16*)(ws + WS_WUP) + (size_t)L * FF * D, M, FF, D}; pg8::StaticOrder S; S.init(M, FF, G, (int)blockIdx.x);
            pg8::EpiBf16<1> E{HB, FF, 0, 1.f, rss_mlp};
            for (int rep = 0; rep < REP_UP; ++rep) pg8::gemm_phase<pg8::EpiBf16<1>, pg8::StaticOrder, true, true>(lds, g, S, E, wave);
        }
        PH_END
        PH_BEGIN
        {
            pg8::Gemm g{HB, (const bf16*)(ws + WS_WDOWN) + (size_t)L * D * FF, M, D, FF}; pg8::StaticOrder S; S.init(M, D, G, (int)blockIdx.x);
            pg8::EpiResid E{xres, xres, D, (L + 1 < DEPTH) ? args.in[I_NMIX] + (size_t)(L + 1) * D : (const float*)nullptr, XN, rss_next};
            pg8::gemm_phase<pg8::EpiResid, pg8::StaticOrder, true, true>(lds, g, S, E, wave);
        }
        PH_END
    }
#undef PH_BEGIN
#undef PH_END
}

#ifndef MK_MULTI
#define MK_MULTI 0
#endif
constexpr int N_PHASES = 1 + 5 + 6 + 5 + 6;

extern "C" void kernel_launch(void* const* d_in, const int* in_sizes, int n_in, void* d_out, int out_size, void* d_ws, size_t ws_size, hipStream_t stream) {
    static int grid = 0;
    if (grid == 0) {
        if (n_in != 12 || out_size != M * D || ws_size < WS_END) { fprintf(stderr, "kernel_launch: unexpected shapes (n_in %d out %d ws %zu)\n", n_in, out_size, ws_size); grid = -1; return; }
        int dev = 0, cus = 0, per_cu = 0;
        if (hipGetDevice(&dev) != hipSuccess || hipDeviceGetAttribute(&cus, hipDeviceAttributeMultiprocessorCount, dev) != hipSuccess) { grid = -1; return; }
        if (hipFuncSetAttribute((const void*)fwd_megakernel, hipFuncAttributeMaxDynamicSharedMemorySize, LDS_BYTES) != hipSuccess) { fprintf(stderr, "kernel_launch: hipFuncSetAttribute failed\n"); grid = -1; return; }
        if (hipOccupancyMaxActiveBlocksPerMultiprocessor(&per_cu, (const void*)fwd_megakernel, NWAVES * 64, LDS_BYTES) != hipSuccess || per_cu < 1) { fprintf(stderr, "kernel_launch: occupancy query gave %d\n", per_cu); per_cu = 1; }
        (void)hipGetLastError();
        grid = cus * per_cu;
    }
    if (grid < 0) return;
    Args a{};
    for (int i = 0; i < 12; ++i) a.in[i] = (const float*)d_in[i];
    a.out = (float*)d_out; a.ws = (unsigned char*)d_ws;
#if MK_MULTI
    for (int p = 0; p < N_PHASES; ++p) { a.ph_lo = p; a.ph_hi = p + 1; hipLaunchKernelGGL(fwd_megakernel, dim3(grid), dim3(NWAVES * 64), LDS_BYTES, stream, a); }
#else
    a.ph_lo = 0; a.ph_hi = N_PHASES;
    void* kargs[] = {&a};
    const hipError_t e = hipLaunchCooperativeKernel((const void*)fwd_megakernel, dim3(grid), dim3(NWAVES * 64), kargs, LDS_BYTES, stream);
    if (e != hipSuccess) fprintf(stderr, "kernel_launch: cooperative launch failed: %s (grid %d)\n", hipGetErrorString(e), grid);
#endif
}
```

```cpp
#include <hip/hip_runtime.h>
#include <hip/hip_cooperative_groups.h>
#include <cstdio>
#include <cstdint>
namespace cg = cooperative_groups;
namespace pg8 {
#define PG8_LAS __attribute__((address_space(3)))
typedef unsigned short bf16_t;
typedef short bf16x8 __attribute__((ext_vector_type(8)));
typedef float f32x4 __attribute__((ext_vector_type(4)));
typedef unsigned u32x4 __attribute__((ext_vector_type(4)));
constexpr int BM = 256, BK = 64, HALF = 128, HTB = HALF * BK * 2  , STAGE_BYTES = 8 * HTB, NXCD = 8, WGM = 8;

__host__ __device__ __forceinline__ int lds_byte(int r, int c) { const int st = (r >> 4) * 2 + (c >> 5), rr = r & 15, cc = c & 31, ob = rr * 64 + cc * 2; return st * 1024 + (ob ^ (((ob >> 9) & 1) << 5)); }
__host__ __device__ __forceinline__ void stage_rc(int b, int& R, int& C) { const int st = b / 1024, sb = b % 1024, swz = sb ^ (((sb >> 9) & 1) << 5); R = (st >> 1) * 16 + swz / 64; C = (st & 1) * 32 + (swz % 64) / 2; }
__host__ __device__ __forceinline__ int perm32(int rho) { const int n = rho >> 4, i = rho & 15; return 8 * (i >> 2) + 4 * n + (i & 3); }

struct Unit { int pm, pn; };
struct Gemm { const bf16_t* A; const bf16_t* Bt; int M, N, K; };

struct StaticOrder {
    int nM, nN, nwg, G, c;
    __host__ __device__ void init(int M, int N, int G_, int c_) { nM = M / BM; nN = N / BM; nwg = nM * nN; G = G_; c = c_; }
    __host__ __device__ bool next(int i, Unit& u) const {
        const long L = (long)i * G + c; if (L >= nwg) return false;
        int wgid = (int)L; { const int q = nwg / NXCD, r = nwg % NXCD, xcd = wgid % NXCD, off = wgid / NXCD; wgid = (xcd < r ? xcd * (q + 1) : r * (q + 1) + (xcd - r) * q) + off; }
        const int nig = WGM * nN, gid = wgid / nig, fm = gid * WGM, gsz = (nM - fm) < WGM ? (nM - fm) : WGM;
        u.pm = fm + ((wgid % nig) % gsz); u.pn = (wgid % nig) / gsz; return true;
    }
    __device__ __forceinline__ void a_ready(const Unit&) const {}
    __device__ __forceinline__ void done(const Unit&) const {}
};

__device__ __forceinline__ unsigned cvt_pk_bf16(float lo, float hi) { unsigned r; asm volatile("v_cvt_pk_bf16_f32 %0, %1, %2" : "=v"(r) : "v"(lo), "v"(hi)); return r; }
typedef unsigned u32x4 __attribute__((ext_vector_type(4)));
template <int ACT> struct EpiBf16 {
    static constexpr bool PERM = true, AFTER_DRAIN = false;
    bf16_t* O; int ldc; int scale_cols; float scale0; const unsigned long long* rowss;
    __device__ __forceinline__ void operator()(const f32x4 (&acc)[2][2][4][2], const Unit& u, int wr, int wc, int fr, int fq) const {
        const int row0 = u.pm * BM + wr * 64 + fr; const int colt = u.pn * BM;
        const float sc = (colt < scale_cols) ? scale0 : 1.f;
        const int col0 = colt + wc * 32 + 8 * fq;
#pragma unroll
        for (int ai = 0; ai < 2; ++ai)
#pragma unroll
            for (int m = 0; m < 4; ++m) { bf16_t* rowp = O + (size_t)(row0 + ai * HALF + m * 16) * ldc + col0;
                const float rs = rowss ? sc * (1.0f / sqrtf((float)__hip_atomic_load(rowss + row0 + ai * HALF + m * 16, __ATOMIC_RELAXED, __HIP_MEMORY_SCOPE_AGENT) * (1.0f / (2048.0f * 1048576.0f)) + 1e-6f)) : sc;
#pragma unroll
                for (int bj = 0; bj < 2; ++bj) { f32x4 v0 = acc[ai][bj][m][0] * rs, v1 = acc[ai][bj][m][1] * rs;
                    if (ACT == 1) {
#pragma unroll
                        for (int e = 0; e < 4; ++e) { float a = v0[e] > 0.f ? v0[e] : 0.f; v0[e] = a * a; float b = v1[e] > 0.f ? v1[e] : 0.f; v1[e] = b * b; } }
                    u32x4 w; w.x = cvt_pk_bf16(v0[0], v0[1]); w.y = cvt_pk_bf16(v0[2], v0[3]); w.z = cvt_pk_bf16(v1[0], v1[1]); w.w = cvt_pk_bf16(v1[2], v1[3]);
                    *(u32x4*)(rowp + bj * HALF) = w; } }
    }
};
typedef unsigned u32x2 __attribute__((ext_vector_type(2)));
struct EpiResid {
    static constexpr bool PERM = false, AFTER_DRAIN = false;
    const float* base; float* out; int ldc; const float* gain; bf16_t* xn; unsigned long long* rowss;
    __device__ __forceinline__ void operator()(const f32x4 (&acc)[2][2][4][2], const Unit& u, int wr, int wc, int fr, int fq) const {
        const int col0 = u.pn * BM + wc * 32 + 4 * fq;
        f32x4 cur[2][2], nxt[2][2], gv[2][2];
        const size_t row00 = (size_t)(u.pm * BM + wr * 64 + fr);
#pragma unroll
        for (int bj = 0; bj < 2; ++bj)
#pragma unroll
            for (int n = 0; n < 2; ++n) gv[bj][n] = gain ? *(const f32x4*)(gain + col0 + bj * HALF + n * 16) : (f32x4){0.f, 0.f, 0.f, 0.f};
#pragma unroll
        for (int bj = 0; bj < 2; ++bj)
#pragma unroll
            for (int n = 0; n < 2; ++n) cur[bj][n] = *(const f32x4*)(base + row00 * ldc + col0 + bj * HALF + n * 16);
#pragma unroll
        for (int g8 = 0; g8 < 8; ++g8) { const int ai = g8 >> 2, m = g8 & 3;
            const int row = u.pm * BM + ai * HALF + wr * 64 + m * 16 + fr; const size_t off = (size_t)row * ldc + col0; float ss = 0.f;
            if (g8 < 7) { const int ai2 = (g8 + 1) >> 2, m2 = (g8 + 1) & 3; const size_t off2 = (size_t)(u.pm * BM + ai2 * HALF + wr * 64 + m2 * 16 + fr) * ldc + col0;
#pragma unroll
                for (int bj = 0; bj < 2; ++bj)
#pragma unroll
                    for (int n = 0; n < 2; ++n) nxt[bj][n] = *(const f32x4*)(base + off2 + bj * HALF + n * 16); }
#pragma unroll
            for (int bj = 0; bj < 2; ++bj)
#pragma unroll
                for (int n = 0; n < 2; ++n) { const f32x4 v = cur[bj][n] + acc[ai][bj][m][n]; *(f32x4*)(out + off + bj * HALF + n * 16) = v;
                    if (gain) { ss += (v[0] * v[0] + v[1] * v[1]) + (v[2] * v[2] + v[3] * v[3]); const f32x4 g = gv[bj][n];
                        u32x2 w; w.x = cvt_pk_bf16(v[0] * g[0], v[1] * g[1]); w.y = cvt_pk_bf16(v[2] * g[2], v[3] * g[3]); *(u32x2*)(xn + off + bj * HALF + n * 16) = w; } }
            if (gain) { ss += __shfl_xor(ss, 16); ss += __shfl_xor(ss, 32); if (fq == 0) __hip_atomic_fetch_add(rowss + row, (unsigned long long)(ss * 1048576.0f), __ATOMIC_RELAXED, __HIP_MEMORY_SCOPE_AGENT); }
#pragma unroll
            for (int bj = 0; bj < 2; ++bj)
#pragma unroll
                for (int n = 0; n < 2; ++n) cur[bj][n] = nxt[bj][n];
        }
    }
};
template <class Epi, class Sched, bool ALIGN_EPI = false, bool SP2 = false>
__device__ __forceinline__ void gemm_phase(PG8_LAS unsigned char* lds, const Gemm g, const Sched& S, const Epi& E, const int wid_in) {
    int tid_ = (wid_in << 6) | __builtin_amdgcn_mbcnt_hi(~0u, __builtin_amdgcn_mbcnt_lo(~0u, 0u)); asm volatile("" : "+v"(tid_)); const int tid = tid_, wid = __builtin_amdgcn_readfirstlane(tid >> 6), lane = tid & 63, wr = wid >> 2, wc = wid & 3, fr = lane & 15, fq = lane >> 4;
    const int K = g.K, nt = K / BK;
    unsigned voffA[2], voffB[2];
#pragma unroll
    for (int i = 0; i < 2; ++i) { int R, C; stage_rc(tid * 16 + i * 8192, R, C); const int Rb = Epi::PERM ? ((R & ~31) + perm32(R & 31)) : R;
        voffA[i] = (unsigned)(R * K + C) * 2u; voffB[i] = (unsigned)(Rb * K + C) * 2u; }
    const size_t kstep = (size_t)(BK * 2);
    const size_t hstep = (size_t)HALF * K * 2;
    const size_t tstep = 2 * hstep;
    const unsigned ldsw = (unsigned)wid * 1024u;
    const int aoff = lds_byte(wr * 64 + fr, fq * 8), boff = lds_byte(wc * 32 + fr, fq * 8);
#define PG8_SA(b, h) (((b) * 2 + (h)) * HTB)
#define PG8_SB(b, h) ((4 + (b) * 2 + (h)) * HTB)
#define PG8_STAGE(bufoff, gbase, voff) do { _Pragma("unroll") for (int _i = 0; _i < 2; ++_i) \
        __builtin_amdgcn_global_load_lds((const unsigned*)((const char*)(gbase) + (voff)[_i]), (PG8_LAS unsigned*)(lds + (bufoff) + ldsw + _i * 8192), 16, 0, 0); } while (0)
#define PG8_LDA(dst, b, h) do { _Pragma("unroll") for (int m = 0; m < 4; ++m) _Pragma("unroll") for (int k = 0; k < 2; ++k) dst[m][k] = *(const PG8_LAS bf16x8*)(lds + PG8_SA(b, h) + aoff + m * 2048 + k * 1024); } while (0)
#define PG8_LDB(dst, b, h) do { _Pragma("unroll") for (int n = 0; n < 2; ++n) _Pragma("unroll") for (int k = 0; k < 2; ++k) dst[n][k] = *(const PG8_LAS bf16x8*)(lds + PG8_SB(b, h) + boff + n * 2048 + k * 1024); } while (0)
#define PG8_MMA(ai, bj, At, Bt) do { __builtin_amdgcn_s_setprio(1); _Pragma("unroll") for (int m = 0; m < 4; ++m) _Pragma("unroll") for (int n = 0; n < 2; ++n) _Pragma("unroll") for (int k = 0; k < 2; ++k) \
        acc[ai][bj][m][n] = __builtin_amdgcn_mfma_f32_16x16x32_bf16(Bt[n][k], At[m][k], acc[ai][bj][m][n], 0, 0, 0); __builtin_amdgcn_s_setprio(0); } while (0)
#define PG8_WAIT_V(n) asm volatile("s_waitcnt vmcnt(" #n ")" ::: "memory")
#define PG8_WAIT_L(n) asm volatile("s_waitcnt lgkmcnt(" #n ")" ::: "memory")
#define PG8_BAR __builtin_amdgcn_s_barrier()
#define PG8_SCHED __builtin_amdgcn_sched_barrier(0)
    Unit cur, nxt; int ui = 0;
    if (!S.next(0, cur)) return;
    f32x4 acc[2][2][4][2];
#pragma unroll
    for (int a = 0; a < 2; ++a)
#pragma unroll
        for (int b = 0; b < 2; ++b)
#pragma unroll
            for (int m = 0; m < 4; ++m)
#pragma unroll
                for (int n = 0; n < 2; ++n) acc[a][b][m][n] = (f32x4){0.f, 0.f, 0.f, 0.f};
    bf16x8 At[4][2], B0[2][2], B1[2][2];
    const char* cA = (const char*)g.A + (size_t)cur.pm * tstep; const char* cB = (const char*)g.Bt + (size_t)cur.pn * tstep;
    S.a_ready(cur);
    if constexpr (SP2) {
        PG8_STAGE(PG8_SB(0, 0), cB, voffB); PG8_STAGE(PG8_SB(0, 1), cB + hstep, voffB); PG8_STAGE(PG8_SA(0, 0), cA, voffA); PG8_STAGE(PG8_SA(0, 1), cA + hstep, voffA);
        if (wr == 1) PG8_BAR;
        PG8_WAIT_V(2); PG8_BAR;
        PG8_STAGE(PG8_SB(1, 0), cB + kstep, voffB); PG8_STAGE(PG8_SA(1, 0), cA + kstep, voffA); PG8_STAGE(PG8_SB(1, 1), cB + hstep + kstep, voffB);
        PG8_WAIT_V(6); PG8_BAR;
    } else {
        PG8_STAGE(PG8_SB(0, 0), cB, voffB); PG8_STAGE(PG8_SA(0, 0), cA, voffA); PG8_STAGE(PG8_SB(0, 1), cB + hstep, voffB); PG8_STAGE(PG8_SA(0, 1), cA + hstep, voffA);
        if (wr == 1) PG8_BAR;
        PG8_WAIT_V(4); PG8_BAR;
        PG8_STAGE(PG8_SB(1, 0), cB + kstep, voffB); PG8_STAGE(PG8_SA(1, 0), cA + kstep, voffA); PG8_STAGE(PG8_SB(1, 1), cB + hstep + kstep, voffB);
        PG8_WAIT_V(6); PG8_BAR;
    }
    for (;;) {
        const bool has_next = S.next(ui + 1, nxt);
        const char* nA = has_next ? (const char*)g.A + (size_t)nxt.pm * tstep : cA; const char* nB = has_next ? (const char*)g.Bt + (size_t)nxt.pn * tstep : cB;
        for (int t = 0; t < nt; t += 2) {
            const bool last = (t == nt - 2);
            const char* a1 = cA + (size_t)(t + 1) * kstep;
            const char* a2 = last ? nA : cA + (size_t)(t + 2) * kstep; const char* b2 = last ? nB : cB + (size_t)(t + 2) * kstep;
            const char* a3 = a2 + kstep; const char* b3 = b2 + kstep;
            if (last && has_next) S.a_ready(nxt);
            if constexpr (SP2) {
            PG8_LDB(B0, 0, 0); PG8_LDB(B1, 0, 1); PG8_SCHED; PG8_LDA(At, 0, 0); PG8_STAGE(PG8_SA(1, 1), a1 + hstep, voffA);
            PG8_WAIT_V(8); PG8_WAIT_L(0); PG8_BAR; PG8_MMA(0, 0, At, B0); PG8_MMA(0, 1, At, B1); PG8_BAR; PG8_SCHED;
            PG8_LDA(At, 0, 1); PG8_STAGE(PG8_SB(0, 0), b2, voffB); PG8_STAGE(PG8_SB(0, 1), b2 + hstep, voffB); PG8_STAGE(PG8_SA(0, 0), a2, voffA);
            PG8_WAIT_V(8); PG8_WAIT_L(0); PG8_BAR; PG8_MMA(1, 0, At, B0); PG8_MMA(1, 1, At, B1); PG8_BAR; PG8_SCHED;
            PG8_LDB(B0, 1, 0); PG8_LDB(B1, 1, 1); PG8_SCHED; PG8_LDA(At, 1, 0); PG8_STAGE(PG8_SA(0, 1), a2 + hstep, voffA);
            PG8_WAIT_V(8); PG8_WAIT_L(0); PG8_BAR; PG8_MMA(0, 0, At, B0); PG8_MMA(0, 1, At, B1); PG8_BAR; PG8_SCHED;
            PG8_LDA(At, 1, 1); PG8_STAGE(PG8_SB(1, 0), b3, voffB); PG8_STAGE(PG8_SB(1, 1), b3 + hstep, voffB); PG8_STAGE(PG8_SA(1, 0), a3, voffA);
            PG8_WAIT_V(8); PG8_WAIT_L(0); PG8_BAR; PG8_MMA(1, 0, At, B0); PG8_MMA(1, 1, At, B1); PG8_BAR; PG8_SCHED;
            } else {
            PG8_LDB(B0, 0, 0); PG8_SCHED; PG8_LDA(At, 0, 0); PG8_STAGE(PG8_SA(1, 1), a1 + hstep, voffA);
            PG8_WAIT_L(8); PG8_BAR; PG8_WAIT_L(0); PG8_MMA(0, 0, At, B0); PG8_BAR; PG8_SCHED;
            PG8_LDB(B1, 0, 1); PG8_STAGE(PG8_SB(0, 0), b2, voffB);
            PG8_BAR; PG8_WAIT_L(0); PG8_MMA(0, 1, At, B1); PG8_BAR;
            PG8_LDA(At, 0, 1); PG8_STAGE(PG8_SA(0, 0), a2, voffA);
            PG8_BAR; PG8_WAIT_L(0); PG8_MMA(1, 0, At, B0); PG8_BAR; PG8_SCHED;
            PG8_STAGE(PG8_SB(0, 1), b2 + hstep, voffB);
            PG8_WAIT_V(6); PG8_BAR; PG8_MMA(1, 1, At, B1); PG8_BAR;
            PG8_LDB(B0, 1, 0); PG8_SCHED; PG8_LDA(At, 1, 0); PG8_STAGE(PG8_SA(0, 1), a2 + hstep, voffA);
            PG8_WAIT_L(8); PG8_BAR; PG8_WAIT_L(0); PG8_MMA(0, 0, At, B0); PG8_BAR; PG8_SCHED;
            PG8_LDB(B1, 1, 1); PG8_STAGE(PG8_SB(1, 0), b3, voffB);
            PG8_BAR; PG8_WAIT_L(0); PG8_MMA(0, 1, At, B1); PG8_BAR;
            PG8_LDA(At, 1, 1); PG8_STAGE(PG8_SA(1, 0), a3, voffA);
            PG8_BAR; PG8_WAIT_L(0); PG8_MMA(1, 0, At, B0); PG8_BAR; PG8_SCHED;
            PG8_STAGE(PG8_SB(1, 1), b3 + hstep, voffB);
            PG8_WAIT_V(6); PG8_BAR; PG8_MMA(1, 1, At, B1); PG8_BAR;
            }
        }
        if constexpr (ALIGN_EPI) { if (wr == 0) PG8_BAR; }
        if constexpr (!Epi::AFTER_DRAIN) { E(acc, cur, wr, wc, fr, fq); S.done(cur); }
        if (!has_next) break;
#pragma unroll
        for (int a = 0; a < 2; ++a)
#pragma unroll
            for (int b = 0; b < 2; ++b)
#pragma unroll
                for (int m = 0; m < 4; ++m)
#pragma unroll
                    for (int n = 0; n < 2; ++n) acc[a][b][m][n] = (f32x4){0.f, 0.f, 0.f, 0.f};
        cur = nxt; cA = nA; cB = nB; ++ui;
        if constexpr (ALIGN_EPI) { if (wr == 1) PG8_BAR; }
    }
    PG8_WAIT_V(0);
    if constexpr (!ALIGN_EPI) { if (wr == 0) PG8_BAR; }
    PG8_BAR;
    if constexpr (Epi::AFTER_DRAIN) { E.fused(acc, cur, wr, wc, fr, fq, lds, wid, lane); S.done(cur); }
#undef PG8_SA
#undef PG8_SB
#undef PG8_STAGE
#undef PG8_LDA
#undef PG8_LDB
#undef PG8_MMA
#undef PG8_WAIT_V
#undef PG8_WAIT_L
#undef PG8_BAR
#undef PG8_SCHED
}
}

#ifndef REP_SEL
#define REP_SEL 1
#endif
#ifndef REP_IDXM
#define REP_IDXM 1
#endif
#ifndef REP_UP
#define REP_UP 1
#endif
#ifndef REP_PRO
#define REP_PRO 1
#endif
#ifndef REP_SYNC
#define REP_SYNC 1
#endif
#ifndef REP_SB
#define REP_SB 1
#endif
#ifndef REP_IDX
#define REP_IDX 1
#endif
#ifndef REP_DSA
#define REP_DSA 1
#endif
constexpr int NBATCH = 4, SEQ = 4096, M = NBATCH * SEQ, D = 2048, FF = 8192, DEPTH = 4;
constexpr int NAIN = 6144;
constexpr int NBIN = 4176, NBP = 4352;
constexpr int CQ = 0, CK = 2048, CV = 2560, CQI = 3072, CKI = 4096, CWI = 4160;
constexpr float RMS_EPS = 1e-6f;
constexpr float LOG2E = 1.4426950408889634f;
constexpr float C2 = 0.08838834764831845f * LOG2E;
constexpr int NWAVES = 8;

constexpr size_t MiB = 1u << 20;
constexpr size_t WS_RSS = 963 * MiB;
constexpr size_t WS_WINA = 1 * MiB;
constexpr size_t WS_WOUTA = 49 * MiB;
constexpr size_t WS_WINB = 65 * MiB;
constexpr size_t WS_WOUTB = 99 * MiB;
constexpr size_t WS_WUP = 115 * MiB;
constexpr size_t WS_WDOWN = 243 * MiB;
constexpr size_t WS_XN = 371 * MiB;
constexpr size_t WS_SEL = 435 * MiB;
constexpr size_t WS_SC = 451 * MiB;
constexpr size_t WS_QKV = 707 * MiB;
constexpr size_t WS_AO = 899 * MiB;
constexpr size_t WS_HB = 707 * MiB;
constexpr size_t WS_END = 964 * MiB;

constexpr int LDS_BYTES = 147456;
constexpr int WLDS = 18432;

#define LAS __attribute__((address_space(3)))
typedef unsigned short bf16;
typedef short bf16x8 __attribute__((ext_vector_type(8)));
typedef short s16x4 __attribute__((ext_vector_type(4)));
typedef float f32x4 __attribute__((ext_vector_type(4)));
typedef float f32x2 __attribute__((ext_vector_type(2)));
typedef float f32x16 __attribute__((ext_vector_type(16)));
typedef unsigned u32x4 __attribute__((ext_vector_type(4)));
typedef unsigned u32x2 __attribute__((ext_vector_type(2)));

__device__ __forceinline__ unsigned pk2(float lo, float hi) { return pg8::cvt_pk_bf16(lo, hi); }
__device__ __forceinline__ float bflo(unsigned w) { return __builtin_bit_cast(float, w << 16); }
__device__ __forceinline__ float bfhi(unsigned w) { return __builtin_bit_cast(float, w & 0xffff0000u); }
__device__ __forceinline__ float wave_sum(float v) {
#pragma unroll
    for (int o = 1; o < 64; o <<= 1) v += __shfl_xor(v, o);
    return v;
}
#define LDS_WAIT() asm volatile("s_waitcnt lgkmcnt(0)" ::: "memory")

struct TItem { const float* W; bf16* WT; int K, N, k0, n0; };
__device__ __forceinline__ void titem_load(const TItem& t, int lane, float (&tv)[32]) {
    const int n = t.n0 + (lane & 31); const float* wp = t.W + (size_t)(t.k0 + (lane >> 5)) * t.N + (n < t.N ? n : 0);
#pragma unroll
    for (int i = 0; i < 32; ++i) tv[i] = wp[(size_t)(2 * i) * t.N];
}
__device__ __forceinline__ void titem_to_lds(const TItem& t, int lane, const float (&tv)[32], LAS float* scr) {
    const bool ok = (t.n0 + (lane & 31)) < t.N;
#pragma unroll
    for (int i = 0; i < 32; ++i) { const int kk = 2 * i + (lane >> 5); scr[kk * 33 + (lane & 31)] = ok ? tv[i] : 0.f; }
}
__device__ __forceinline__ void titem_store(const TItem& t, int lane, const LAS float* scr) {
    const int c = lane & 7;
#pragma unroll
    for (int j = 0; j < 4; ++j) { const int nn = (lane >> 3) + 8 * j; const LAS float* s = scr + (8 * c) * 33 + nn;
        u32x4 o; o.x = pk2(s[0 * 33], s[1 * 33]); o.y = pk2(s[2 * 33], s[3 * 33]); o.z = pk2(s[4 * 33], s[5 * 33]); o.w = pk2(s[6 * 33], s[7 * 33]);
        *(u32x4*)(t.WT + (size_t)(t.n0 + nn) * t.K + t.k0 + 8 * c) = o; }
}
__device__ __forceinline__ void rms_row(const float* xrow, const float* g, bf16* orow, int lane) {
    const f32x4* xr = (const f32x4*)xrow + lane; const f32x4* gr = (const f32x4*)g + lane;
    f32x4 v[8]; float s = 0.f;
#pragma unroll
    for (int j = 0; j < 8; ++j) { v[j] = xr[64 * j]; s += (v[j].x * v[j].x + v[j].y * v[j].y) + (v[j].z * v[j].z + v[j].w * v[j].w); }
    const float rstd = 1.0f / sqrtf(wave_sum(s) * (1.f / D) + RMS_EPS);
    u32x2* o8 = (u32x2*)orow + lane;
#pragma unroll
    for (int j = 0; j < 8; ++j) { const f32x4 gg = gr[64 * j]; u32x2 w; w.x = pk2(v[j].x * rstd * gg.x, v[j].y * rstd * gg.y); w.y = pk2(v[j].z * rstd * gg.z, v[j].w * rstd * gg.w); o8[64 * j] = w; }
}
__device__ __forceinline__ void norm_phase(const float* x, const float* g, bf16* xn, int gw, int ngw, int lane) {
    for (int m = gw; m < M; m += ngw) rms_row(x + (size_t)m * D, g, xn + (size_t)m * D, lane);
}

__device__ __forceinline__ s16x4 vtr(const LAS unsigned char* p) { return __builtin_bit_cast(s16x4, __builtin_amdgcn_ds_read_tr16_b64_v4i16((LAS s16x4*)p)); }
__device__ __forceinline__ float softplus2(float z2) {
    const float e = __builtin_amdgcn_exp2f(-__builtin_fabsf(z2));
    return __builtin_fmaxf(z2, 0.f) + __builtin_amdgcn_logf(1.0f + e);
}
__device__ __forceinline__ void sb_unit(const bf16* QKV, bf16* AO, int b, int h, int qblk, LAS unsigned char* wl, int lane) {
    const int qi = lane & 31, hi = lane >> 5;
    const int t0 = qblk * 32, t = t0 + qi;
    const size_t rowbase = (size_t)b * SEQ;
    bf16x8 qf[8];
    { const bf16* qp = QKV + (rowbase + t0 + qi) * NAIN + h * 128 + 8 * hi;
#pragma unroll
      for (int ks = 0; ks < 8; ++ks) qf[ks] = *(const bf16x8*)(qp + 16 * ks); }
    f32x16 o[4];
#pragma unroll
    for (int c = 0; c < 4; ++c)
#pragma unroll
        for (int r = 0; r < 16; ++r) o[c][r] = 0.f;
    float C = 0.f;
    const int km = 16 * (qi >> 4) + 8 * ((qi >> 2) & 1) + 4 * ((qi >> 3) & 1) + (qi & 3);
    const int trow = 8 * hi + ((lane & 15) >> 2), tcol = 16 * ((lane >> 4) & 1) + 4 * (lane & 3);
    const LAS unsigned char* vbase = wl + trow * 288 + tcol * 2;
    const int ktop = qblk;
    for (int kt = ktop; kt >= 0; --kt) {
        const int k0 = kt * 32;
        { const bf16* vp = QKV + (rowbase + k0 + (lane >> 4)) * NAIN + 2 * D + h * 128 + (lane & 15) * 8;
          LAS unsigned char* dst = wl + (lane >> 4) * 288 + (lane & 15) * 16;
          LAS unsigned char* kdst = wl + 9216 + (lane >> 4) * 272 + (lane & 15) * 16;
          bf16x8 tmp[8], tk[8];
#pragma unroll
          for (int i = 0; i < 8; ++i) tk[i] = *(const bf16x8*)(vp - D + (size_t)(4 * i) * NAIN);
#pragma unroll
          for (int i = 0; i < 8; ++i) tmp[i] = *(const bf16x8*)(vp + (size_t)(4 * i) * NAIN);
#pragma unroll
          for (int i = 0; i < 8; ++i) *(LAS bf16x8*)(kdst + (4 * i) * 272) = tk[i];
#pragma unroll
          for (int i = 0; i < 8; ++i) *(LAS bf16x8*)(dst + (4 * i) * 288) = tmp[i];
        }
        asm volatile("" ::: "memory");
        f32x16 p0;
#pragma unroll
        for (int r = 0; r < 16; ++r) p0[r] = 0.f;
        { const LAS unsigned char* kf = wl + 9216 + km * 272 + 16 * hi;
          LDS_WAIT();
#pragma unroll
          for (int ks = 0; ks < 8; ++ks) { const bf16x8 a0 = *(const LAS bf16x8*)(kf + 32 * ks); p0 = __builtin_amdgcn_mfma_f32_32x32x16_bf16(a0, qf[ks], p0, 0, 0, 0); } }
        f32x16 s0;
#pragma unroll
        for (int r = 0; r < 16; ++r) s0[r] = softplus2(p0[r]);
        if (kt == ktop) {
#pragma unroll
            for (int r = 0; r < 16; ++r) { const int key0 = k0 + 16 * (r >> 3) + 8 * hi + (r & 7);
                if (key0 >= t) { s0[r] = 0.f; p0[r] = -__builtin_inff(); } }
        }
        float T0 = 0.f, T1 = 0.f;
#pragma unroll
        for (int r = 0; r < 8; ++r) { T0 += s0[r]; T1 += s0[8 + r]; }
        const float U0 = __shfl_xor(T0, 32), U1 = __shfl_xor(T1, 32);
        const float b1 = C, b0 = b1 + T1 + U1;
        const float Cn = b0 + T0 + U0;
        float run1 = b1 + (hi ? 0.f : U1), run0 = b0 + (hi ? 0.f : U0);
#pragma unroll
        for (int r = 7; r >= 0; --r) {
            run1 += s0[8 + r]; p0[8 + r] = __builtin_amdgcn_exp2f(p0[8 + r] - run1);
            run0 += s0[r];     p0[r]     = __builtin_amdgcn_exp2f(p0[r] - run0);
        }
        C = Cn;
        bf16x8 pf[2];
        { u32x4 w;
          w.x = pk2(p0[0], p0[1]); w.y = pk2(p0[2], p0[3]); w.z = pk2(p0[4], p0[5]); w.w = pk2(p0[6], p0[7]); pf[0] = __builtin_bit_cast(bf16x8, w);
          w.x = pk2(p0[8], p0[9]); w.y = pk2(p0[10], p0[11]); w.z = pk2(p0[12], p0[13]); w.w = pk2(p0[14], p0[15]); pf[1] = __builtin_bit_cast(bf16x8, w); }
        LDS_WAIT();
#pragma unroll
        for (int c = 0; c < 4; ++c)
#pragma unroll
            for (int ks = 0; ks < 2; ++ks) {
                const s16x4 lo = vtr(vbase + (16 * ks) * 288 + c * 64), hh = vtr(vbase + (16 * ks + 4) * 288 + c * 64);
                const bf16x8 vf = (bf16x8){lo[0], lo[1], lo[2], lo[3], hh[0], hh[1], hh[2], hh[3]};
                o[c] = __builtin_amdgcn_mfma_f32_32x32x16_bf16(pf[ks], vf, o[c], 0, 0, 0);
            }
        LDS_WAIT();
        if (__all(C >= 151.0f)) break;
    }
    bf16* op = AO + (rowbase + t0) * D + h * 128 + (lane & 31);
#pragma unroll
    for (int c = 0; c < 4; ++c)
#pragma unroll
        for (int r = 0; r < 16; ++r) { const int row = (r & 3) + 8 * (r >> 2) + 4 * hi; op[(size_t)row * D + 32 * c] = (bf16)(pk2(o[c][r], 0.f) & 0xffffu); }
}

__device__ __forceinline__ unsigned fkey(float f) { const unsigned u = __builtin_bit_cast(unsigned, f); return (u & 0x80000000u) ? ~u : (u | 0x80000000u); }
__device__ __forceinline__ int mbcnt(unsigned long long m) { return __builtin_amdgcn_mbcnt_hi((unsigned)(m >> 32), __builtin_amdgcn_mbcnt_lo((unsigned)m, 0u)); }

#define PIN8(m) asm volatile("" : "+s"(m[0]), "+s"(m[1]), "+s"(m[2]), "+s"(m[3]), "+s"(m[4]), "+s"(m[5]), "+s"(m[6]), "+s"(m[7]))
__device__ __forceinline__ void select_query(const float* sc, int* sel, int ce, int lane) {
    const int nreg = ce >> 6;
    unsigned key[64];
    {
        float raw[64];
#pragma unroll
        for (int g = 0; g < 8; ++g) {
            if (8 * g < nreg) {
#pragma unroll
                for (int j = 8 * g; j < 8 * g + 8; ++j) raw[j] = sc[lane + 64 * j];
            } else {
#pragma unroll
                for (int j = 8 * g; j < 8 * g + 8; ++j) raw[j] = 0.f;
            }
        }
#pragma unroll
        for (int j = 0; j < 64; ++j) key[j] = (j < nreg) ? fkey(raw[j]) : 0u;
    }
    unsigned prefix = 0u; bool exact = false;
    for (int bit = 31; bit >= 0; --bit) {
        const unsigned cand = prefix | (1u << bit);
        int cnt = 0;
#pragma unroll
        for (int g = 0; g < 8; ++g) if (8 * g < nreg) {
            unsigned long long m[8];
#pragma unroll
            for (int j = 0; j < 8; ++j) m[j] = __ballot(key[8 * g + j] >= cand);
            PIN8(m);
#pragma unroll
            for (int j = 0; j < 8; ++j) cnt += __builtin_popcountll(m[j]);
            asm volatile("" : "+s"(cnt));
        }
        if (cnt >= 256) prefix = cand;
        if (cnt == 256) { exact = true; break; }
    }
    const unsigned thr = exact ? prefix - 1u : prefix;
    int pos = 0;
#pragma unroll
    for (int g = 0; g < 8; ++g) if (8 * g < nreg) {
        unsigned long long m[8];
#pragma unroll
        for (int j = 0; j < 8; ++j) m[j] = __ballot(key[8 * g + j] > thr);
        PIN8(m);
#pragma unroll
        for (int j = 0; j < 8; ++j) { if (key[8 * g + j] > thr) sel[pos + mbcnt(m[j])] = lane + 64 * (8 * g + j); pos += __builtin_popcountll(m[j]); }
        asm volatile("" : "+s"(pos));
    }
    int need = 256 - pos;
    if (need > 0)
#pragma unroll
    for (int g = 0; g < 8; ++g) if (8 * g < nreg) {
        unsigned long long m[8];
#pragma unroll
        for (int j = 0; j < 8; ++j) m[j] = __ballot(key[8 * g + j] == prefix);
        PIN8(m);
#pragma unroll
        for (int j = 0; j < 8; ++j) { const int rank = mbcnt(m[j]);
            if (key[8 * g + j] == prefix && rank < need) sel[pos + rank] = lane + 64 * (8 * g + j);
            const int c = __builtin_popcountll(m[j]); const int take = c < need ? c : need; pos += take; need -= take; }
        asm volatile("" : "+s"(pos), "+s"(need));
    }
}

__device__ __forceinline__ void idx_unit(bf16* QB, float* SC, int* SEL, const float* qg, const float* kg, int b, int tp, LAS unsigned char* wl, int lane, bool do_norm) {
    const int t = 4 * tp; const size_t rowbase = (size_t)b * SEQ; const size_t row = rowbase + t;
    const int n = lane & 31, hi = lane >> 5;
    const int ce = ((t >> 6) + 1) << 6;
    if (ce > 256) {
        bf16x8 af[2][4];
#pragma unroll
        for (int q2 = 0; q2 < 2; ++q2) { const bf16* ap = QB + (row + 2 * q2 + (n >> 4)) * NBP + CQI + (n & 15) * 64 + 8 * hi;
#pragma unroll
          for (int ks = 0; ks < 4; ++ks) af[q2][ks] = *(const bf16x8*)(ap + 16 * ks); }
        float w[4][8];
#pragma unroll
        for (int a = 0; a < 4; ++a)
#pragma unroll
            for (int r = 0; r < 8; ++r) { const int hh = (r & 3) + 8 * (r >> 2) + 4 * hi; w[a][r] = 0.25f * bflo((unsigned)QB[(row + a) * NBP + CWI + hh]); }
        float* scw0 = SC + (row + hi) * SEQ + n; float* scw1 = scw0 + 2 * (size_t)SEQ;
        const int r8 = lane >> 3, c8 = lane & 7;
        const bf16* kg8 = QB + (rowbase + r8) * NBP + CKI + c8 * 8;
        LAS unsigned char* sdst = wl + r8 * 144 + c8 * 16;
        const LAS unsigned char* fsrc = wl + n * 144 + 16 * hi;
        bf16x8 cur[8];
#pragma unroll
        for (int i = 0; i < 8; ++i) cur[i] = *(const bf16x8*)(kg8 + (size_t)(8 * i) * NBP);
        for (int s0 = 0; s0 < ce; s0 += 64) {
#pragma unroll
            for (int i = 0; i < 8; ++i) *(LAS bf16x8*)(sdst + (8 * i) * 144) = cur[i];
            const int sn = (s0 + 64 < ce) ? s0 + 64 : 0;
#pragma unroll
            for (int i = 0; i < 8; ++i) cur[i] = *(const bf16x8*)(kg8 + (size_t)(sn + 8 * i) * NBP);
            LDS_WAIT();
#pragma unroll
            for (int tt = 0; tt < 2; ++tt) {
                f32x16 acc0, acc1;
#pragma unroll
                for (int r = 0; r < 16; ++r) { acc0[r] = 0.f; acc1[r] = 0.f; }
#pragma unroll
                for (int ks = 0; ks < 4; ++ks) { const bf16x8 bfr = *(const LAS bf16x8*)(fsrc + tt * 32 * 144 + 32 * ks);
                    acc0 = __builtin_amdgcn_mfma_f32_32x32x16_bf16(af[0][ks], bfr, acc0, 0, 0, 0); acc1 = __builtin_amdgcn_mfma_f32_32x32x16_bf16(af[1][ks], bfr, acc1, 0, 0, 0); }
                float pa = 0.f, pb = 0.f, pc = 0.f, pd = 0.f;
#pragma unroll
                for (int r = 0; r < 8; ++r) { pa += w[0][r] * (__builtin_fmaxf(acc0[r], 0.f) * 0.125f); pb += w[1][r] * (__builtin_fmaxf(acc0[8 + r], 0.f) * 0.125f);
                                              pc += w[2][r] * (__builtin_fmaxf(acc1[r], 0.f) * 0.125f); pd += w[3][r] * (__builtin_fmaxf(acc1[8 + r], 0.f) * 0.125f); }
                const float snd0 = hi ? pa : pb, snd1 = hi ? pc : pd; const float rcv0 = __shfl_xor(snd0, 32), rcv1 = __shfl_xor(snd1, 32);
                scw0[s0 + 32 * tt] = (hi ? pb : pa) + rcv0;
                scw1[s0 + 32 * tt] = (hi ? pd : pc) + rcv1;
            }
            LDS_WAIT();
        }
        __builtin_amdgcn_fence(__ATOMIC_SEQ_CST, "workgroup");
        asm volatile("s_waitcnt vmcnt(0)" ::: "memory");
#pragma unroll 1
        for (int a = 0; a < 4; ++a) select_query(SC + (row + a) * SEQ, SEL + (row + a) * 256, ce, lane);
    } else {
#pragma unroll
        for (int i = 0; i < 4; ++i) { const int p = lane + 64 * i; if (p < ce) {
#pragma unroll
            for (int a = 0; a < 4; ++a) SEL[(row + a) * 256 + p] = p; } }
    }
    if (!do_norm) return;
    const int lg = lane >> 4, li = lane & 15;
#pragma unroll 1
    for (int a = 0; a < 4; ++a)
#pragma unroll 1
        for (int p = 0; p < 5; ++p) {
            const int col = (p < 4) ? (CQ + (4 * p + lg) * 128) : (CK + lg * 128);
            bf16* ptr = QB + (row + a) * NBP + col + 8 * li;
            const u32x4 w = *(const u32x4*)ptr;
            float v[8] = {bflo(w.x), bfhi(w.x), bflo(w.y), bfhi(w.y), bflo(w.z), bfhi(w.z), bflo(w.w), bfhi(w.w)};
            float s = 0.f;
#pragma unroll
            for (int e = 0; e < 8; ++e) s += v[e] * v[e];
            s += __shfl_xor(s, 1); s += __shfl_xor(s, 2); s += __shfl_xor(s, 4); s += __shfl_xor(s, 8);
            const float rstd = (1.0f / sqrtf(s * (1.f / 128.f) + RMS_EPS)) * ((p < 4) ? C2 : 1.f);
            const float* gp = ((p < 4) ? qg : kg) + 8 * li;
            const f32x4 g0 = *(const f32x4*)gp, g1 = *(const f32x4*)(gp + 4);
            u32x4 o; o.x = pk2(v[0] * rstd * g0.x, v[1] * rstd * g0.y); o.y = pk2(v[2] * rstd * g0.z, v[3] * rstd * g0.w);
            o.z = pk2(v[4] * rstd * g1.x, v[5] * rstd * g1.y); o.w = pk2(v[6] * rstd * g1.z, v[7] * rstd * g1.w);
            *(u32x4*)ptr = o;
        }
}

__device__ __forceinline__ int t5_bucket(int rel) {
    const int nabs = rel < 0 ? -rel : rel;
    int bk = nabs;
    if (nabs >= 8) bk = 8 + (nabs >= 12) + (nabs >= 16) + (nabs >= 23) + (nabs >= 32) + (nabs >= 46) + (nabs >= 64) + (nabs >= 91);
    return bk + (rel > 0 ? 16 : 0);
}
typedef float f32x4v __attribute__((ext_vector_type(4)));
__device__ __forceinline__ void dsa_unit(const bf16* QB, const int* SEL, bf16* AO, int b, int kvh, int t, LAS unsigned char* wl, int lane) {
    const size_t rowbase = (size_t)b * SEQ, row = rowbase + t;
    const int n = lane & 31, hi = lane >> 5, l15 = lane & 15, kq = lane >> 4;
    const int ce = ((t >> 6) + 1) << 6; const int nsel = ce < 256 ? ce : 256;
    LAS unsigned char* buf = wl;
    LAS bf16* pT = (LAS bf16*)(wl + 9216);
    LAS int* il = (LAS int*)(wl + 11264);
    const LAS float* bl = (const LAS float*)(wl + 12288) + kvh * 128;
    int sidx[8];
#pragma unroll
    for (int kb = 0; kb < 8; ++kb) { const int p = 32 * kb + n; sidx[kb] = (p < nsel) ? SEL[row * 256 + p] : 0; }
    bf16x8 qf[4];
    { const bf16* qp = QB + row * NBP + CQ + (kvh * 4 + (l15 & 3)) * 128 + 8 * kq;
#pragma unroll
      for (int ks = 0; ks < 4; ++ks) qf[ks] = *(const bf16x8*)(qp + 32 * ks); }
    if (hi == 0) {
#pragma unroll
        for (int kb = 0; kb < 8; ++kb) il[32 * kb + n] = sidx[kb];
    }
    LDS_WAIT();
    const int r4 = kq, c16 = l15;
    const bf16* kg = QB + rowbase * NBP + CK + kvh * 128 + c16 * 8;
    const bf16* vg = QB + rowbase * NBP + CV + kvh * 128 + c16 * 8;
    bf16x8 kr[3][8];
#pragma unroll
    for (int pb = 0; pb < 3; ++pb)
#pragma unroll
        for (int i = 0; i < 8; ++i) kr[pb][i] = *(const bf16x8*)(kg + (size_t)il[32 * pb + 4 * i + r4] * NBP);
    float lg[8][4];
    float mx[4] = {-__builtin_inff(), -__builtin_inff(), -__builtin_inff(), -__builtin_inff()};
    LAS unsigned char* kdst = buf + r4 * 272 + c16 * 16;
    const LAS unsigned char* kfb = buf + l15 * 272 + 16 * kq;
    const bool upper = (lane >> 4) & 1;
#pragma unroll
    for (int kb = 0; kb < 8; ++kb) {
#pragma unroll
        for (int i = 0; i < 8; ++i) *(LAS bf16x8*)(kdst + (4 * i) * 272) = kr[kb % 3][i];
        if (kb + 3 < 8) {
#pragma unroll
            for (int i = 0; i < 8; ++i) kr[kb % 3][i] = *(const bf16x8*)(kg + (size_t)il[32 * (kb + 3) + 4 * i + r4] * NBP);
        }
        LDS_WAIT();
        f32x4v a0 = {0.f, 0.f, 0.f, 0.f}, a1 = {0.f, 0.f, 0.f, 0.f};
#pragma unroll
        for (int ks = 0; ks < 4; ++ks) { const bf16x8 b0 = *(const LAS bf16x8*)(kfb + 64 * ks), b1 = *(const LAS bf16x8*)(kfb + 16 * 272 + 64 * ks);
            a0 = __builtin_amdgcn_mfma_f32_16x16x32_bf16(qf[ks], b0, a0, 0, 0, 0); a1 = __builtin_amdgcn_mfma_f32_16x16x32_bf16(qf[ks], b1, a1, 0, 0, 0); }
        LDS_WAIT();
        const int bk = t5_bucket(sidx[kb] - t);
        const bool valid = (32 * kb + n) < nsel;
#pragma unroll
        for (int g = 0; g < 4; ++g) { const float raw = upper ? a1[g] : a0[g]; const float v = valid ? raw + bl[g * 32 + bk] : -__builtin_inff(); lg[kb][g] = v; mx[g] = __builtin_fmaxf(mx[g], v); }
    }
    bf16x8 vr[3][8];
#pragma unroll
    for (int pb = 0; pb < 3; ++pb)
#pragma unroll
        for (int i = 0; i < 8; ++i) vr[pb][i] = *(const bf16x8*)(vg + (size_t)il[32 * pb + 4 * i + r4] * NBP);
#pragma unroll
    for (int g = 0; g < 4; ++g) {
        float m = mx[g];
        m = __builtin_fmaxf(m, __shfl_xor(m, 1)); m = __builtin_fmaxf(m, __shfl_xor(m, 2)); m = __builtin_fmaxf(m, __shfl_xor(m, 4)); m = __builtin_fmaxf(m, __shfl_xor(m, 8)); m = __builtin_fmaxf(m, __shfl_xor(m, 16));
        float s = 0.f;
#pragma unroll
        for (int kb = 0; kb < 8; ++kb) { const float e = __builtin_amdgcn_exp2f(lg[kb][g] - m); lg[kb][g] = e; s += e; }
        s += __shfl_xor(s, 1); s += __shfl_xor(s, 2); s += __shfl_xor(s, 4); s += __shfl_xor(s, 8); s += __shfl_xor(s, 16);
        const float inv = 1.0f / s;
#pragma unroll
        for (int kb = 0; kb < 8; ++kb) if ((kb >> 2) == hi) pT[g * 256 + 32 * kb + n] = (bf16)(pk2(lg[kb][g] * inv, 0.f) & 0xffffu);
    }
    f32x4v o[8];
#pragma unroll
    for (int c = 0; c < 8; ++c) o[c] = (f32x4v){0.f, 0.f, 0.f, 0.f};
    const LAS unsigned char* vtb = buf + (8 * kq + (l15 >> 2)) * 288 + (lane & 3) * 8;
    LAS unsigned char* vdst = buf + r4 * 288 + c16 * 16;
    const LAS bf16* pfp = pT + (l15 & 3) * 256 + 8 * kq;
#pragma unroll
    for (int ch = 0; ch < 8; ++ch) {
#pragma unroll
        for (int i = 0; i < 8; ++i) *(LAS bf16x8*)(vdst + (4 * i) * 288) = vr[ch % 3][i];
        if (ch + 3 < 8) {
#pragma unroll
            for (int i = 0; i < 8; ++i) vr[ch % 3][i] = *(const bf16x8*)(vg + (size_t)il[32 * (ch + 3) + 4 * i + r4] * NBP);
        }
        const bf16x8 pf = *(const LAS bf16x8*)(pfp + 32 * ch);
        LDS_WAIT();
#pragma unroll
        for (int c = 0; c < 8; ++c) {
            const s16x4 lo = vtr(vtb + c * 32), hh = vtr(vtb + 4 * 288 + c * 32);
            o[c] = __builtin_amdgcn_mfma_f32_16x16x32_bf16(pf, (bf16x8){lo[0], lo[1], lo[2], lo[3], hh[0], hh[1], hh[2], hh[3]}, o[c], 0, 0, 0);
        }
        LDS_WAIT();
    }
    bf16* op = AO + row * D + (kvh * 4) * 128 + 16 * kq + l15;
#pragma unroll
    for (int i = 0; i < 2; ++i)
#pragma unroll
        for (int g = 0; g < 4; ++g) {
            const float v = (kq == 0) ? o[4 * i][g] : (kq == 1) ? o[4 * i + 1][g] : (kq == 2) ? o[4 * i + 2][g] : o[4 * i + 3][g];
            op[g * 128 + 64 * i] = (bf16)(pk2(v, 0.f) & 0xffffu);
        }
}

__device__ __forceinline__ unsigned xcc_id() { return (unsigned)__builtin_amdgcn_s_getreg((3 << 11) | 20) & 0xFu; }
__device__ __forceinline__ void grid_barrier(unsigned* bar, unsigned round, unsigned xcc, unsigned gsz, unsigned nx) {
    asm volatile("s_waitcnt vmcnt(0) lgkmcnt(0)" ::: "memory");
    __syncthreads();
    if (threadIdx.x == 0) {
        const unsigned old = __hip_atomic_fetch_add(bar + 64 * (1 + xcc), 1u, __ATOMIC_RELAXED, __HIP_MEMORY_SCOPE_AGENT);
        if (old + 1u == gsz * round) {
            __builtin_amdgcn_fence(__ATOMIC_RELEASE, "agent");
            asm volatile("s_waitcnt vmcnt(0)" ::: "memory");
            __hip_atomic_fetch_add(bar, 1u, __ATOMIC_RELAXED, __HIP_MEMORY_SCOPE_AGENT);
        }
        while (__hip_atomic_load(bar, __ATOMIC_RELAXED, __HIP_MEMORY_SCOPE_AGENT) < nx * round) __builtin_amdgcn_s_sleep(1);
        __builtin_amdgcn_fence(__ATOMIC_ACQUIRE, "agent");
        asm volatile("s_waitcnt vmcnt(0)" ::: "memory");
    }
    __syncthreads();
}

struct Args { const float* in[12]; float* out; unsigned char* ws; int ph_lo, ph_hi; };
enum { I_X = 0, I_NMIX, I_WINA, I_WOUTA, I_WINB, I_WOUTB, I_QN, I_KN, I_RELB, I_NMLP, I_WUP, I_WDOWN };

__global__ void __launch_bounds__(NWAVES * 64, 2) fwd_megakernel(Args args) {
    extern __shared__ __attribute__((aligned(16))) unsigned char lds_raw[];
    LAS unsigned char* lds = (LAS unsigned char*)lds_raw;
    cg::grid_group grid = cg::this_grid();
    const int wave = __builtin_amdgcn_readfirstlane((int)threadIdx.x >> 6);
    const int G = gridDim.x, gw = blockIdx.x * NWAVES + wave, ngw = G * NWAVES;
    LAS unsigned char* wl = lds + wave * WLDS;
    unsigned char* ws = args.ws;
    const float* x_in = args.in[I_X];
    float* xres = args.out;
    bf16* XN = (bf16*)(ws + WS_XN); bf16* QKV = (bf16*)(ws + WS_QKV); bf16* AO = (bf16*)(ws + WS_AO); bf16* HB = (bf16*)(ws + WS_HB);
    int* SEL = (int*)(ws + WS_SEL); float* SC = (float*)(ws + WS_SC);
    const int lo = args.ph_lo, hi = args.ph_hi;
    int ph = 0;
    unsigned* bar_ctr = (unsigned*)ws; unsigned bar_target = 0u; const unsigned bar_xcc = xcc_id(); unsigned bar_gsz = 1u, bar_nx = 1u;
#define PH_BEGIN if (ph >= lo && ph < hi) { int lane = __builtin_amdgcn_mbcnt_hi(~0u, __builtin_amdgcn_mbcnt_lo(~0u, 0u)); asm volatile("" : "+v"(lane));
#define PH_END if (ph + 1 < hi) { for (int rsy = 0; rsy < REP_SYNC; ++rsy) { if (ph == lo) { grid.sync(); unsigned c_ = 0u, n_ = 0u; for (unsigned j_ = 0; j_ < 16u; ++j_) { const unsigned v_ = __hip_atomic_load(bar_ctr + 64 * (17 + j_), __ATOMIC_RELAXED, __HIP_MEMORY_SCOPE_AGENT); n_ += (v_ != 0u); if (j_ == bar_xcc) c_ = v_; } bar_gsz = __builtin_amdgcn_readfirstlane(c_); bar_nx = __builtin_amdgcn_readfirstlane(n_); } else { bar_target += 1u; grid_barrier(bar_ctr, bar_target, bar_xcc, bar_gsz, bar_nx); } } } } ++ph;

    PH_BEGIN
    {
        LAS float* scr = (LAS float*)wl;
        constexpr int I_A = 32 * (NAIN / 32), I_O = 32 * (D / 32), I_B = 32 * (NBP / 32), I_U = 32 * (FF / 32), I_DN = (FF / 64) * (D / 32);
        constexpr int NITEMS = 2 * I_A + 2 * I_O + 2 * I_B + 2 * I_O + 4 * I_U + 4 * I_DN;
        auto decode = [&](int it) -> TItem {
            int r = it; const float* W; bf16* WT; int K, N, Np, l, q;
            if (r < 2 * I_A) { l = r / I_A; q = r % I_A; W = args.in[I_WINA] + (size_t)l * D * NAIN; WT = (bf16*)(ws + WS_WINA) + (size_t)l * NAIN * D; K = D; N = NAIN; Np = NAIN; }
            else if ((r -= 2 * I_A) < 2 * I_O) { l = r / I_O; q = r % I_O; W = args.in[I_WOUTA] + (size_t)l * D * D; WT = (bf16*)(ws + WS_WOUTA) + (size_t)l * D * D; K = D; N = D; Np = D; }
            else if ((r -= 2 * I_O) < 2 * I_B) { l = r / I_B; q = r % I_B; W = args.in[I_WINB] + (size_t)l * D * NBIN; WT = (bf16*)(ws + WS_WINB) + (size_t)l * NBP * D; K = D; N = NBIN; Np = NBP; }
            else if ((r -= 2 * I_B) < 2 * I_O) { l = r / I_O; q = r % I_O; W = args.in[I_WOUTB] + (size_t)l * D * D; WT = (bf16*)(ws + WS_WOUTB) + (size_t)l * D * D; K = D; N = D; Np = D; }
            else if ((r -= 2 * I_O) < 4 * I_U) { l = r / I_U; q = r % I_U; W = args.in[I_WUP] + (size_t)l * D * FF; WT = (bf16*)(ws + WS_WUP) + (size_t)l * FF * D; K = D; N = FF; Np = FF; }
            else { r -= 4 * I_U; l = r / I_DN; q = r % I_DN; W = args.in[I_WDOWN] + (size_t)l * FF * D; WT = (bf16*)(ws + WS_WDOWN) + (size_t)l * D * FF; K = FF; N = D; Np = D; }
            const int nblk = Np / 32; TItem t; t.W = W; t.WT = WT; t.K = K; t.N = N; t.k0 = 64 * (q / nblk); t.n0 = 32 * (q % nblk); return t; };
        float tv[32];
        if (gw < NITEMS) { const TItem t0 = decode(gw); titem_load(t0, lane, tv); }
        for (int rep = 0; rep < REP_PRO; ++rep)
        for (int it = gw; it < NITEMS; it += ngw) {
            const TItem t = decode(it);
            titem_to_lds(t, lane, tv, scr);
            { const int nx = (it + ngw < NITEMS) ? it + ngw : it; const TItem tn = decode(nx); titem_load(tn, lane, tv); }
            LDS_WAIT();
            titem_store(t, lane, scr);
            LDS_WAIT();
        }
        norm_phase(x_in, args.in[I_NMIX], XN, gw, ngw, lane);
        if (wave == 0 && lane == 0) __hip_atomic_fetch_add(bar_ctr + 64 * (17 + bar_xcc), 1u, __ATOMIC_RELAXED, __HIP_MEMORY_SCOPE_AGENT);
        { unsigned long long* z = (unsigned long long*)(ws + WS_RSS); for (int i = gw * 64 + lane; i < 8 * M; i += ngw * 64) __hip_atomic_store(z + i, 0ull, __ATOMIC_RELAXED, __HIP_MEMORY_SCOPE_AGENT); }
        __syncthreads();
    }
    PH_END

#pragma unroll 1
    for (int L = 0; L < DEPTH; ++L) {
        const int j = L >> 1; const bool isA = (L & 1) == 0;
        const float* xbase = (L == 0) ? x_in : xres;
        unsigned long long* rss_all = (unsigned long long*)(ws + WS_RSS);
        const unsigned long long* rss_mix = (L == 0) ? (const unsigned long long*)nullptr : rss_all + (size_t)(2 * L - 1) * M;
        unsigned long long* rss_mlp = rss_all + (size_t)(2 * L) * M; unsigned long long* rss_next = rss_all + (size_t)(2 * L + 1) * M;
        PH_BEGIN
        if (isA) {
            pg8::Gemm g{XN, (const bf16*)(ws + WS_WINA) + (size_t)j * NAIN * D, M, NAIN, D}; pg8::StaticOrder S; S.init(M, NAIN, G, (int)blockIdx.x);
            pg8::EpiBf16<0> E{QKV, NAIN, D, C2, rss_mix};
            pg8::gemm_phase<pg8::EpiBf16<0>, pg8::StaticOrder, true, true>(lds, g, S, E, wave);
        } else {
            pg8::Gemm g{XN, (const bf16*)(ws + WS_WINB) + (size_t)j * NBP * D, M, NBP, D}; pg8::StaticOrder S; S.init(M, NBP, G, (int)blockIdx.x);
            pg8::EpiBf16<0> E{QKV, NBP, 0, 1.f, rss_mix};
            pg8::gemm_phase<pg8::EpiBf16<0>, pg8::StaticOrder, true, true>(lds, g, S, E, wave);
        }
        PH_END
        if (isA) {
            PH_BEGIN
            for (int rep = 0; rep < REP_SB; ++rep) for (int u = gw; u < NBATCH * 16 * (SEQ / 32); u += ngw) { const int qblk = u % (SEQ / 32), bh = u / (SEQ / 32);
#ifndef NO_SB
 sb_unit(QKV, AO, bh >> 4, bh & 15, qblk, wl, lane);
#endif
 }
            __syncthreads();
            PH_END
        } else {
            PH_BEGIN
            {
                const int per = SEQ / 4;
                for (int rep = 0; rep < REP_IDX; ++rep) for (int i = 0; i * ngw < NBATCH * per; ++i) { const int u = i * ngw + gw; if (u >= NBATCH * per) break;
                    const int bb = u / per; int tp = u % per; if (i & 1) tp = per - 1 - tp;

#ifndef NO_IDX
 idx_unit(QKV, SC, SEL, args.in[I_QN] + j * 128, args.in[I_KN] + j * 128, bb, tp, wl, lane, rep == REP_IDX - 1);
#endif
 }
                __syncthreads();
            }
            PH_END
            PH_BEGIN
            {
                { LAS float* blw = (LAS float*)(wl + 12288);
#pragma unroll
                  for (int i = 0; i < 8; ++i) blw[lane + 64 * i] = LOG2E * args.in[I_RELB][lane + 64 * i];
                  LDS_WAIT(); }
                for (int rep = 0; rep < REP_DSA; ++rep)
                if ((G & 7) == 0) { const int x = blockIdx.x & 7; const int nxw = (G >> 3) * NWAVES; const int wx = (blockIdx.x >> 3) * NWAVES + wave;
                    for (int i = wx; i < 2 * SEQ; i += nxw) { const int combo = x + 8 * (i / SEQ);
#ifndef NO_DSA
 dsa_unit(QKV, SEL, AO, combo >> 2, combo & 3, i % SEQ, wl, lane);
#endif
 } }
                else { for (int i = gw; i < 16 * SEQ; i += ngw) { const int combo = i / SEQ;
#ifndef NO_DSA
 dsa_unit(QKV, SEL, AO, combo >> 2, combo & 3, i % SEQ, wl, lane);
#endif
 } }
                __syncthreads();
            }
            PH_END
        }
        PH_BEGIN
        {
            const bf16* wo = isA ? (const bf16*)(ws + WS_WOUTA) + (size_t)j * D * D : (const bf16*)(ws + WS_WOUTB) + (size_t)j * D * D;
            pg8::Gemm g{AO, wo, M, D, D}; pg8::StaticOrder S; S.init(M, D, G, (int)blockIdx.x);
            pg8::EpiResid E{xbase, xres, D, args.in[I_NMLP] + (size_t)L * D, XN, rss_mlp};
            pg8::gemm_phase<pg8::EpiResid, pg8::StaticOrder, true, true>(lds, g, S, E, wave);
        }
        PH_END
        PH_BEGIN
        {
            pg8::Gemm g{XN, (const bf16*)(ws + WS_WUP) + (size_t)L * FF * D, M, FF, D}; pg8::StaticOrder S; S.init(M, FF, G, (int)blockIdx.x);
            pg8::EpiBf16<1> E{HB, FF, 0, 1.f, rss_mlp};
            for (int rep = 0; rep < REP_UP; ++rep) pg8::gemm_phase<pg8::EpiBf16<1>, pg8::StaticOrder, true, true>(lds, g, S, E, wave);
        }
        PH_END
        PH_BEGIN
        {
            pg8::Gemm g{HB, (const bf16*)(ws + WS_WDOWN) + (size_t)L * D * FF, M, D, FF}; pg8::StaticOrder S; S.init(M, D, G, (int)blockIdx.x);
            pg8::EpiResid E{xres, xres, D, (L + 1 < DEPTH) ? args.in[I_NMIX] + (size_t)(L + 1) * D : (const float*)nullptr, XN, rss_next};
            pg8::gemm_phase<pg8::EpiResid, pg8::StaticOrder, true, true>(lds, g, S, E, wave);
        }
        PH_END
    }
#undef PH_BEGIN
#undef PH_END
}

#ifndef MK_MULTI
#define MK_MULTI 0
#endif
constexpr int N_PHASES = 1 + 5 + 6 + 5 + 6;

extern "C" void kernel_launch(void* const* d_in, const int* in_sizes, int n_in, void* d_out, int out_size, void* d_ws, size_t ws_size, hipStream_t stream) {
    static int grid = 0;
    if (grid == 0) {
        if (n_in != 12 || out_size != M * D || ws_size < WS_END) { fprintf(stderr, "kernel_launch: unexpected shapes (n_in %d out %d ws %zu)\n", n_in, out_size, ws_size); grid = -1; return; }
        int dev = 0, cus = 0, per_cu = 0;
        if (hipGetDevice(&dev) != hipSuccess || hipDeviceGetAttribute(&cus, hipDeviceAttributeMultiprocessorCount, dev) != hipSuccess) { grid = -1; return; }
        if (hipFuncSetAttribute((const void*)fwd_megakernel, hipFuncAttributeMaxDynamicSharedMemorySize, LDS_BYTES) != hipSuccess) { fprintf(stderr, "kernel_launch: hipFuncSetAttribute failed\n"); grid = -1; return; }
        if (hipOccupancyMaxActiveBlocksPerMultiprocessor(&per_cu, (const void*)fwd_megakernel, NWAVES * 64, LDS_BYTES) != hipSuccess || per_cu < 1) { fprintf(stderr, "kernel_launch: occupancy query gave %d\n", per_cu); per_cu = 1; }
        (void)hipGetLastError();
        grid = cus * per_cu;
    }
    if (grid < 0) return;
    Args a{};
    for (int i = 0; i < 12; ++i) a.in[i] = (const float*)d_in[i];
    a.out = (float*)d_out; a.ws = (unsigned char*)d_ws;
#if MK_MULTI
    for (int p = 0; p < N_PHASES; ++p) { a.ph_lo = p; a.ph_hi = p + 1; hipLaunchKernelGGL(fwd_megakernel, dim3(grid), dim3(NWAVES * 64), LDS_BYTES, stream, a); }
#else
    a.ph_lo = 0; a.ph_hi = N_PHASES;
    if (hipMemsetAsync(d_ws, 0, 16384, stream) != hipSuccess) { fprintf(stderr, "kernel_launch: memset of the barrier words failed\n"); return; }
    void* kargs[] = {&a};
    const hipError_t e = hipLaunchCooperativeKernel((const void*)fwd_megakernel, dim3(grid), dim3(NWAVES * 64), kargs, LDS_BYTES, stream);
    if (e != hipSuccess) fprintf(stderr, "kernel_launch: cooperative launch failed: %s (grid %d)\n", hipGetErrorString(e), grid);
#endif
}
```

```cpp
#include <hip/hip_runtime.h>
#include <hip/hip_cooperative_groups.h>
#include <cstdio>
#include <cstdint>
namespace cg = cooperative_groups;
namespace pg8 {
#define PG8_LAS __attribute__((address_space(3)))
typedef unsigned short bf16_t;
typedef short bf16x8 __attribute__((ext_vector_type(8)));
typedef float f32x4 __attribute__((ext_vector_type(4)));
typedef unsigned u32x4 __attribute__((ext_vector_type(4)));
constexpr int BM = 256, BK = 64, HALF = 128, HTB = HALF * BK * 2  , STAGE_BYTES = 8 * HTB, NXCD = 8, WGM = 8;

__host__ __device__ __forceinline__ int lds_byte(int r, int c) { const int st = (r >> 4) * 2 + (c >> 5), rr = r & 15, cc = c & 31, ob = rr * 64 + cc * 2; return st * 1024 + (ob ^ (((ob >> 9) & 1) << 5)); }
__host__ __device__ __forceinline__ void stage_rc(int b, int& R, int& C) { const int st = b / 1024, sb = b % 1024, swz = sb ^ (((sb >> 9) & 1) << 5); R = (st >> 1) * 16 + swz / 64; C = (st & 1) * 32 + (swz % 64) / 2; }
__host__ __device__ __forceinline__ int perm32(int rho) { const int n = rho >> 4, i = rho & 15; return 8 * (i >> 2) + 4 * n + (i & 3); }

struct Unit { int pm, pn; };
struct Gemm { const bf16_t* A; const bf16_t* Bt; int M, N, K; };

struct StaticOrder {
    int nM, nN, nwg, G, c;
    __host__ __device__ void init(int M, int N, int G_, int c_) { nM = M / BM; nN = N / BM; nwg = nM * nN; G = G_; c = c_; }
    __host__ __device__ bool next(int i, Unit& u) const {
        const long L = (long)i * G + c; if (L >= nwg) return false;
        int wgid = (int)L; { const int q = nwg / NXCD, r = nwg % NXCD, xcd = wgid % NXCD, off = wgid / NXCD; wgid = (xcd < r ? xcd * (q + 1) : r * (q + 1) + (xcd - r) * q) + off; }
        const int nig = WGM * nN, gid = wgid / nig, fm = gid * WGM, gsz = (nM - fm) < WGM ? (nM - fm) : WGM;
        u.pm = fm + ((wgid % nig) % gsz); u.pn = (wgid % nig) / gsz; return true;
    }
    __device__ __forceinline__ void a_ready(const Unit&) const {}
    __device__ __forceinline__ void done(const Unit&) const {}
};

__device__ __forceinline__ unsigned cvt_pk_bf16(float lo, float hi) { unsigned r; asm volatile("v_cvt_pk_bf16_f32 %0, %1, %2" : "=v"(r) : "v"(lo), "v"(hi)); return r; }
typedef unsigned u32x4 __attribute__((ext_vector_type(4)));
template <int ACT> struct EpiBf16 {
    static constexpr bool PERM = true, AFTER_DRAIN = false;
    bf16_t* O; int ldc; int scale_cols; float scale0; const unsigned long long* rowss;
    __device__ __forceinline__ void operator()(const f32x4 (&acc)[2][2][4][2], const Unit& u, int wr, int wc, int fr, int fq) const {
        const int row0 = u.pm * BM + wr * 64 + fr; const int colt = u.pn * BM;
        const float sc = (colt < scale_cols) ? scale0 : 1.f;
        const int col0 = colt + wc * 32 + 8 * fq;
#pragma unroll
        for (int ai = 0; ai < 2; ++ai)
#pragma unroll
            for (int m = 0; m < 4; ++m) { bf16_t* rowp = O + (size_t)(row0 + ai * HALF + m * 16) * ldc + col0;
                const float rs = rowss ? sc * (1.0f / sqrtf((float)__hip_atomic_load(rowss + row0 + ai * HALF + m * 16, __ATOMIC_RELAXED, __HIP_MEMORY_SCOPE_AGENT) * (1.0f / (2048.0f * 1048576.0f)) + 1e-6f)) : sc;
#pragma unroll
                for (int bj = 0; bj < 2; ++bj) { f32x4 v0 = acc[ai][bj][m][0] * rs, v1 = acc[ai][bj][m][1] * rs;
                    if (ACT == 1) {
#pragma unroll
                        for (int e = 0; e < 4; ++e) { float a = v0[e] > 0.f ? v0[e] : 0.f; v0[e] = a * a; float b = v1[e] > 0.f ? v1[e] : 0.f; v1[e] = b * b; } }
                    u32x4 w; w.x = cvt_pk_bf16(v0[0], v0[1]); w.y = cvt_pk_bf16(v0[2], v0[3]); w.z = cvt_pk_bf16(v1[0], v1[1]); w.w = cvt_pk_bf16(v1[2], v1[3]);
                    *(u32x4*)(rowp + bj * HALF) = w; } }
    }
};
typedef unsigned u32x2 __attribute__((ext_vector_type(2)));
struct EpiResid {
    static constexpr bool PERM = false, AFTER_DRAIN = false;
    const float* base; float* out; int ldc; const float* gain; bf16_t* xn; unsigned long long* rowss;
    __device__ __forceinline__ void operator()(const f32x4 (&acc)[2][2][4][2], const Unit& u, int wr, int wc, int fr, int fq) const {
        const int col0 = u.pn * BM + wc * 32 + 4 * fq;
        f32x4 cur[2][2], nxt[2][2], gv[2][2];
        const size_t row00 = (size_t)(u.pm * BM + wr * 64 + fr);
#pragma unroll
        for (int bj = 0; bj < 2; ++bj)
#pragma unroll
            for (int n = 0; n < 2; ++n) gv[bj][n] = gain ? *(const f32x4*)(gain + col0 + bj * HALF + n * 16) : (f32x4){0.f, 0.f, 0.f, 0.f};
#pragma unroll
        for (int bj = 0; bj < 2; ++bj)
#pragma unroll
            for (int n = 0; n < 2; ++n) cur[bj][n] = *(const f32x4*)(base + row00 * ldc + col0 + bj * HALF + n * 16);
#pragma unroll
        for (int g8 = 0; g8 < 8; ++g8) { const int ai = g8 >> 2, m = g8 & 3;
            const int row = u.pm * BM + ai * HALF + wr * 64 + m * 16 + fr; const size_t off = (size_t)row * ldc + col0; float ss = 0.f;
            if (g8 < 7) { const int ai2 = (g8 + 1) >> 2, m2 = (g8 + 1) & 3; const size_t off2 = (size_t)(u.pm * BM + ai2 * HALF + wr * 64 + m2 * 16 + fr) * ldc + col0;
#pragma unroll
                for (int bj = 0; bj < 2; ++bj)
#pragma unroll
                    for (int n = 0; n < 2; ++n) nxt[bj][n] = *(const f32x4*)(base + off2 + bj * HALF + n * 16); }
#pragma unroll
            for (int bj = 0; bj < 2; ++bj)
#pragma unroll
                for (int n = 0; n < 2; ++n) { const f32x4 v = cur[bj][n] + acc[ai][bj][m][n]; *(f32x4*)(out + off + bj * HALF + n * 16) = v;
                    if (gain) { ss += (v[0] * v[0] + v[1] * v[1]) + (v[2] * v[2] + v[3] * v[3]); const f32x4 g = gv[bj][n];
                        u32x2 w; w.x = cvt_pk_bf16(v[0] * g[0], v[1] * g[1]); w.y = cvt_pk_bf16(v[2] * g[2], v[3] * g[3]); *(u32x2*)(xn + off + bj * HALF + n * 16) = w; } }
            if (gain) { ss += __shfl_xor(ss, 16); ss += __shfl_xor(ss, 32); if (fq == 0) __hip_atomic_fetch_add(rowss + row, (unsigned long long)(ss * 1048576.0f), __ATOMIC_RELAXED, __HIP_MEMORY_SCOPE_AGENT); }
#pragma unroll
            for (int bj = 0; bj < 2; ++bj)
#pragma unroll
                for (int n = 0; n < 2; ++n) cur[bj][n] = nxt[bj][n];
        }
    }
};
template <class Epi, class Sched, bool ALIGN_EPI = false, bool SP2 = false>
__device__ __forceinline__ void gemm_phase(PG8_LAS unsigned char* lds, const Gemm g, const Sched& S, const Epi& E, const int wid_in) {
    int tid_ = (wid_in << 6) | __builtin_amdgcn_mbcnt_hi(~0u, __builtin_amdgcn_mbcnt_lo(~0u, 0u)); asm volatile("" : "+v"(tid_)); const int tid = tid_, wid = __builtin_amdgcn_readfirstlane(tid >> 6), lane = tid & 63, wr = wid >> 2, wc = wid & 3, fr = lane & 15, fq = lane >> 4;
    const int K = g.K, nt = K / BK;
    unsigned voffA[2], voffB[2];
#pragma unroll
    for (int i = 0; i < 2; ++i) { int R, C; stage_rc(tid * 16 + i * 8192, R, C); const int Rb = Epi::PERM ? ((R & ~31) + perm32(R & 31)) : R;
        voffA[i] = (unsigned)(R * K + C) * 2u; voffB[i] = (unsigned)(Rb * K + C) * 2u; }
    const size_t kstep = (size_t)(BK * 2);
    const size_t hstep = (size_t)HALF * K * 2;
    const size_t tstep = 2 * hstep;
    const unsigned ldsw = (unsigned)wid * 1024u;
    const int aoff = lds_byte(wr * 64 + fr, fq * 8), boff = lds_byte(wc * 32 + fr, fq * 8);
#define PG8_SA(b, h) (((b) * 2 + (h)) * HTB)
#define PG8_SB(b, h) ((4 + (b) * 2 + (h)) * HTB)
#define PG8_STAGE(bufoff, gbase, voff) do { _Pragma("unroll") for (int _i = 0; _i < 2; ++_i) \
        __builtin_amdgcn_global_load_lds((const unsigned*)((const char*)(gbase) + (voff)[_i]), (PG8_LAS unsigned*)(lds + (bufoff) + ldsw + _i * 8192), 16, 0, 0); } while (0)
#define PG8_LDA(dst, b, h) do { _Pragma("unroll") for (int m = 0; m < 4; ++m) _Pragma("unroll") for (int k = 0; k < 2; ++k) dst[m][k] = *(const PG8_LAS bf16x8*)(lds + PG8_SA(b, h) + aoff + m * 2048 + k * 1024); } while (0)
#define PG8_LDB(dst, b, h) do { _Pragma("unroll") for (int n = 0; n < 2; ++n) _Pragma("unroll") for (int k = 0; k < 2; ++k) dst[n][k] = *(const PG8_LAS bf16x8*)(lds + PG8_SB(b, h) + boff + n * 2048 + k * 1024); } while (0)
#define PG8_MMA(ai, bj, At, Bt) do { __builtin_amdgcn_s_setprio(1); _Pragma("unroll") for (int m = 0; m < 4; ++m) _Pragma("unroll") for (int n = 0; n < 2; ++n) _Pragma("unroll") for (int k = 0; k < 2; ++k) \
        acc[ai][bj][m][n] = __builtin_amdgcn_mfma_f32_16x16x32_bf16(Bt[n][k], At[m][k], acc[ai][bj][m][n], 0, 0, 0); __builtin_amdgcn_s_setprio(0); } while (0)
#define PG8_WAIT_V(n) asm volatile("s_waitcnt vmcnt(" #n ")" ::: "memory")
#define PG8_WAIT_L(n) asm volatile("s_waitcnt lgkmcnt(" #n ")" ::: "memory")
#define PG8_BAR __builtin_amdgcn_s_barrier()
#define PG8_SCHED __builtin_amdgcn_sched_barrier(0)
    Unit cur, nxt; int ui = 0;
    if (!S.next(0, cur)) return;
    f32x4 acc[2][2][4][2];
#pragma unroll
    for (int a = 0; a < 2; ++a)
#pragma unroll
        for (int b = 0; b < 2; ++b)
#pragma unroll
            for (int m = 0; m < 4; ++m)
#pragma unroll
                for (int n = 0; n < 2; ++n) acc[a][b][m][n] = (f32x4){0.f, 0.f, 0.f, 0.f};
    bf16x8 At[4][2], B0[2][2], B1[2][2];
    const char* cA = (const char*)g.A + (size_t)cur.pm * tstep; const char* cB = (const char*)g.Bt + (size_t)cur.pn * tstep;
    S.a_ready(cur);
    if constexpr (SP2) {
        PG8_STAGE(PG8_SB(0, 0), cB, voffB); PG8_STAGE(PG8_SB(0, 1), cB + hstep, voffB); PG8_STAGE(PG8_SA(0, 0), cA, voffA); PG8_STAGE(PG8_SA(0, 1), cA + hstep, voffA);
        if (wr == 1) PG8_BAR;
        PG8_WAIT_V(2); PG8_BAR;
        PG8_STAGE(PG8_SB(1, 0), cB + kstep, voffB); PG8_STAGE(PG8_SA(1, 0), cA + kstep, voffA); PG8_STAGE(PG8_SB(1, 1), cB + hstep + kstep, voffB);
        PG8_WAIT_V(6); PG8_BAR;
    } else {
        PG8_STAGE(PG8_SB(0, 0), cB, voffB); PG8_STAGE(PG8_SA(0, 0), cA, voffA); PG8_STAGE(PG8_SB(0, 1), cB + hstep, voffB); PG8_STAGE(PG8_SA(0, 1), cA + hstep, voffA);
        if (wr == 1) PG8_BAR;
        PG8_WAIT_V(4); PG8_BAR;
        PG8_STAGE(PG8_SB(1, 0), cB + kstep, voffB); PG8_STAGE(PG8_SA(1, 0), cA + kstep, voffA); PG8_STAGE(PG8_SB(1, 1), cB + hstep + kstep, voffB);
        PG8_WAIT_V(6); PG8_BAR;
    }
    for (;;) {
        const bool has_next = S.next(ui + 1, nxt);
        const char* nA = has_next ? (const char*)g.A + (size_t)nxt.pm * tstep : cA; const char* nB = has_next ? (const char*)g.Bt + (size_t)nxt.pn * tstep : cB;
        for (int t = 0; t < nt; t += 2) {
            const bool last = (t == nt - 2);
            const char* a1 = cA + (size_t)(t + 1) * kstep;
            const char* a2 = last ? nA : cA + (size_t)(t + 2) * kstep; const char* b2 = last ? nB : cB + (size_t)(t + 2) * kstep;
            const char* a3 = a2 + kstep; const char* b3 = b2 + kstep;
            if (last && has_next) S.a_ready(nxt);
            if constexpr (SP2) {
            PG8_LDB(B0, 0, 0); PG8_LDB(B1, 0, 1); PG8_SCHED; PG8_LDA(At, 0, 0); PG8_STAGE(PG8_SA(1, 1), a1 + hstep, voffA);
            PG8_WAIT_V(8); PG8_WAIT_L(0); PG8_BAR; PG8_MMA(0, 0, At, B0); PG8_MMA(0, 1, At, B1); PG8_BAR; PG8_SCHED;
            PG8_LDA(At, 0, 1); PG8_STAGE(PG8_SB(0, 0), b2, voffB); PG8_STAGE(PG8_SB(0, 1), b2 + hstep, voffB); PG8_STAGE(PG8_SA(0, 0), a2, voffA);
            PG8_WAIT_V(8); PG8_WAIT_L(0); PG8_BAR; PG8_MMA(1, 0, At, B0); PG8_MMA(1, 1, At, B1); PG8_BAR; PG8_SCHED;
            PG8_LDB(B0, 1, 0); PG8_LDB(B1, 1, 1); PG8_SCHED; PG8_LDA(At, 1, 0); PG8_STAGE(PG8_SA(0, 1), a2 + hstep, voffA);
            PG8_WAIT_V(8); PG8_WAIT_L(0); PG8_BAR; PG8_MMA(0, 0, At, B0); PG8_MMA(0, 1, At, B1); PG8_BAR; PG8_SCHED;
            PG8_LDA(At, 1, 1); PG8_STAGE(PG8_SB(1, 0), b3, voffB); PG8_STAGE(PG8_SB(1, 1), b3 + hstep, voffB); PG8_STAGE(PG8_SA(1, 0), a3, voffA);
            PG8_WAIT_V(8); PG8_WAIT_L(0); PG8_BAR; PG8_MMA(1, 0, At, B0); PG8_MMA(1, 1, At, B1); PG8_BAR; PG8_SCHED;
            } else {
            PG8_LDB(B0, 0, 0); PG8_SCHED; PG8_LDA(At, 0, 0); PG8_STAGE(PG8_SA(1, 1), a1 + hstep, voffA);
            PG8_WAIT_L(8); PG8_BAR; PG8_WAIT_L(0); PG8_MMA(0, 0, At, B0); PG8_BAR; PG8_SCHED;
            PG8_LDB(B1, 0, 1); PG8_STAGE(PG8_SB(0, 0), b2, voffB);
            PG8_BAR; PG8_WAIT_L(0); PG8_MMA(0, 1, At, B1); PG8_BAR;
            PG8_LDA(At, 0, 1); PG8_STAGE(PG8_SA(0, 0), a2, voffA);
            PG8_BAR; PG8_WAIT_L(0); PG8_MMA(1, 0, At, B0); PG8_BAR; PG8_SCHED;
            PG8_STAGE(PG8_SB(0, 1), b2 + hstep, voffB);
            PG8_WAIT_V(6); PG8_BAR; PG8_MMA(1, 1, At, B1); PG8_BAR;
            PG8_LDB(B0, 1, 0); PG8_SCHED; PG8_LDA(At, 1, 0); PG8_STAGE(PG8_SA(0, 1), a2 + hstep, voffA);
            PG8_WAIT_L(8); PG8_BAR; PG8_WAIT_L(0); PG8_MMA(0, 0, At, B0); PG8_BAR; PG8_SCHED;
            PG8_LDB(B1, 1, 1); PG8_STAGE(PG8_SB(1, 0), b3, voffB);
            PG8_BAR; PG8_WAIT_L(0); PG8_MMA(0, 1, At, B1); PG8_BAR;
            PG8_LDA(At, 1, 1); PG8_STAGE(PG8_SA(1, 0), a3, voffA);
            PG8_BAR; PG8_WAIT_L(0); PG8_MMA(1, 0, At, B0); PG8_BAR; PG8_SCHED;
            PG8_STAGE(PG8_SB(1, 1), b3 + hstep, voffB);
            PG8_WAIT_V(6); PG8_BAR; PG8_MMA(1, 1, At, B1); PG8_BAR;
            }
        }
        if constexpr (ALIGN_EPI) { if (wr == 0) PG8_BAR; }
        if constexpr (!Epi::AFTER_DRAIN) { E(acc, cur, wr, wc, fr, fq); S.done(cur); }
        if (!has_next) break;
#pragma unroll
        for (int a = 0; a < 2; ++a)
#pragma unroll
            for (int b = 0; b < 2; ++b)
#pragma unroll
                for (int m = 0; m < 4; ++m)
#pragma unroll
                    for (int n = 0; n < 2; ++n) acc[a][b][m][n] = (f32x4){0.f, 0.f, 0.f, 0.f};
        cur = nxt; cA = nA; cB = nB; ++ui;
        if constexpr (ALIGN_EPI) { if (wr == 1) PG8_BAR; }
    }
    PG8_WAIT_V(0);
    if constexpr (!ALIGN_EPI) { if (wr == 0) PG8_BAR; }
    PG8_BAR;
    if constexpr (Epi::AFTER_DRAIN) { E.fused(acc, cur, wr, wc, fr, fq, lds, wid, lane); S.done(cur); }
#undef PG8_SA
#undef PG8_SB
#undef PG8_STAGE
#undef PG8_LDA
#undef PG8_LDB
#undef PG8_MMA
#undef PG8_WAIT_V
#undef PG8_WAIT_L
#undef PG8_BAR
#undef PG8_SCHED
}
}

#ifndef REP_SEL
#define REP_SEL 1
#endif
#ifndef REP_IDXM
#define REP_IDXM 1
#endif
#ifndef REP_UP
#define REP_UP 1
#endif
#ifndef REP_PRO
#define REP_PRO 1
#endif
#ifndef REP_SYNC
#define REP_SYNC 1
#endif
#ifndef REP_SB
#define REP_SB 1
#endif
#ifndef REP_IDX
#define REP_IDX 1
#endif
#ifndef REP_DSA
#define REP_DSA 1
#endif
constexpr int NBATCH = 4, SEQ = 4096, M = NBATCH * SEQ, D = 2048, FF = 8192, DEPTH = 4;
constexpr int NAIN = 6144;
constexpr int NBIN = 4176, NBP = 4352;
constexpr int CQ = 0, CK = 2048, CV = 2560, CQI = 3072, CKI = 4096, CWI = 4160;
constexpr float RMS_EPS = 1e-6f;
constexpr float LOG2E = 1.4426950408889634f;
constexpr float C2 = 0.08838834764831845f * LOG2E;
constexpr int NWAVES = 8;

constexpr size_t MiB = 1u << 20;
constexpr size_t WS_RSS = 963 * MiB;
constexpr size_t WS_WINA = 1 * MiB;
constexpr size_t WS_WOUTA = 49 * MiB;
constexpr size_t WS_WINB = 65 * MiB;
constexpr size_t WS_WOUTB = 99 * MiB;
constexpr size_t WS_WUP = 115 * MiB;
constexpr size_t WS_WDOWN = 243 * MiB;
constexpr size_t WS_XN = 371 * MiB;
constexpr size_t WS_SEL = 435 * MiB;
constexpr size_t WS_SC = 451 * MiB;
constexpr size_t WS_QKV = 707 * MiB;
constexpr size_t WS_AO = 899 * MiB;
constexpr size_t WS_HB = 707 * MiB;
constexpr size_t WS_END = 964 * MiB;

constexpr int LDS_BYTES = 147456;
constexpr int WLDS = 18432;

#define LAS __attribute__((address_space(3)))
typedef unsigned short bf16;
typedef short bf16x8 __attribute__((ext_vector_type(8)));
typedef short s16x4 __attribute__((ext_vector_type(4)));
typedef float f32x4 __attribute__((ext_vector_type(4)));
typedef float f32x2 __attribute__((ext_vector_type(2)));
typedef float f32x16 __attribute__((ext_vector_type(16)));
typedef unsigned u32x4 __attribute__((ext_vector_type(4)));
typedef unsigned u32x2 __attribute__((ext_vector_type(2)));

__device__ __forceinline__ unsigned pk2(float lo, float hi) { return pg8::cvt_pk_bf16(lo, hi); }
__device__ __forceinline__ float bflo(unsigned w) { return __builtin_bit_cast(float, w << 16); }
__device__ __forceinline__ float bfhi(unsigned w) { return __builtin_bit_cast(float, w & 0xffff0000u); }
__device__ __forceinline__ float wave_sum(float v) {
#pragma unroll
    for (int o = 1; o < 64; o <<= 1) v += __shfl_xor(v, o);
    return v;
}
#define LDS_WAIT() asm volatile("s_waitcnt lgkmcnt(0)" ::: "memory")

struct TItem { const float* W; bf16* WT; int K, N, k0, n0; };
__device__ __forceinline__ void titem_load(const TItem& t, int lane, float (&tv)[32]) {
    const int n = t.n0 + (lane & 31); const float* wp = t.W + (size_t)(t.k0 + (lane >> 5)) * t.N + (n < t.N ? n : 0);
#pragma unroll
    for (int i = 0; i < 32; ++i) tv[i] = wp[(size_t)(2 * i) * t.N];
}
__device__ __forceinline__ void titem_to_lds(const TItem& t, int lane, const float (&tv)[32], LAS float* scr) {
    const bool ok = (t.n0 + (lane & 31)) < t.N;
#pragma unroll
    for (int i = 0; i < 32; ++i) { const int kk = 2 * i + (lane >> 5); scr[kk * 33 + (lane & 31)] = ok ? tv[i] : 0.f; }
}
__device__ __forceinline__ void titem_store(const TItem& t, int lane, const LAS float* scr) {
    const int c = lane & 7;
#pragma unroll
    for (int j = 0; j < 4; ++j) { const int nn = (lane >> 3) + 8 * j; const LAS float* s = scr + (8 * c) * 33 + nn;
        u32x4 o; o.x = pk2(s[0 * 33], s[1 * 33]); o.y = pk2(s[2 * 33], s[3 * 33]); o.z = pk2(s[4 * 33], s[5 * 33]); o.w = pk2(s[6 * 33], s[7 * 33]);
        *(u32x4*)(t.WT + (size_t)(t.n0 + nn) * t.K + t.k0 + 8 * c) = o; }
}
__device__ __forceinline__ void rms_row(const float* xrow, const float* g, bf16* orow, int lane) {
    const f32x4* xr = (const f32x4*)xrow + lane; const f32x4* gr = (const f32x4*)g + lane;
    f32x4 v[8]; float s = 0.f;
#pragma unroll
    for (int j = 0; j < 8; ++j) { v[j] = xr[64 * j]; s += (v[j].x * v[j].x + v[j].y * v[j].y) + (v[j].z * v[j].z + v[j].w * v[j].w); }
    const float rstd = 1.0f / sqrtf(wave_sum(s) * (1.f / D) + RMS_EPS);
    u32x2* o8 = (u32x2*)orow + lane;
#pragma unroll
    for (int j = 0; j < 8; ++j) { const f32x4 gg = gr[64 * j]; u32x2 w; w.x = pk2(v[j].x * rstd * gg.x, v[j].y * rstd * gg.y); w.y = pk2(v[j].z * rstd * gg.z, v[j].w * rstd * gg.w); o8[64 * j] = w; }
}
__device__ __forceinline__ void norm_phase(const float* x, const float* g, bf16* xn, int gw, int ngw, int lane) {
    for (int m = gw; m < M; m += ngw) rms_row(x + (size_t)m * D, g, xn + (size_t)m * D, lane);
}

__device__ __forceinline__ s16x4 vtr(const LAS unsigned char* p) { return __builtin_bit_cast(s16x4, __builtin_amdgcn_ds_read_tr16_b64_v4i16((LAS s16x4*)p)); }
__device__ __forceinline__ float softplus2(float z2) {
    const float e = __builtin_amdgcn_exp2f(-__builtin_fabsf(z2));
    return __builtin_fmaxf(z2, 0.f) + __builtin_amdgcn_logf(1.0f + e);
}
__device__ __forceinline__ void sb_unit(const bf16* QKV, bf16* AO, int b, int h, int qblk, LAS unsigned char* wl, int lane) {
    const int qi = lane & 31, hi = lane >> 5;
    const int t0 = qblk * 32, t = t0 + qi;
    const size_t rowbase = (size_t)b * SEQ;
    bf16x8 qf[8];
    { const bf16* qp = QKV + (rowbase + t0 + qi) * NAIN + h * 128 + 8 * hi;
#pragma unroll
      for (int ks = 0; ks < 8; ++ks) qf[ks] = *(const bf16x8*)(qp + 16 * ks); }
    f32x16 o[4];
#pragma unroll
    for (int c = 0; c < 4; ++c)
#pragma unroll
        for (int r = 0; r < 16; ++r) o[c][r] = 0.f;
    float C = 0.f;
    const int km = 16 * (qi >> 4) + 8 * ((qi >> 2) & 1) + 4 * ((qi >> 3) & 1) + (qi & 3);
    const int trow = 8 * hi + ((lane & 15) >> 2), tcol = 16 * ((lane >> 4) & 1) + 4 * (lane & 3);
    const LAS unsigned char* vbase = wl + trow * 288 + tcol * 2;
    const int ktop = qblk;
    for (int kt = ktop; kt >= 0; --kt) {
        const int k0 = kt * 32;
        { const bf16* vp = QKV + (rowbase + k0 + (lane >> 4)) * NAIN + 2 * D + h * 128 + (lane & 15) * 8;
          LAS unsigned char* dst = wl + (lane >> 4) * 288 + (lane & 15) * 16;
          LAS unsigned char* kdst = wl + 9216 + (lane >> 4) * 272 + (lane & 15) * 16;
          bf16x8 tmp[8], tk[8];
#pragma unroll
          for (int i = 0; i < 8; ++i) tk[i] = *(const bf16x8*)(vp - D + (size_t)(4 * i) * NAIN);
#pragma unroll
          for (int i = 0; i < 8; ++i) tmp[i] = *(const bf16x8*)(vp + (size_t)(4 * i) * NAIN);
#pragma unroll
          for (int i = 0; i < 8; ++i) *(LAS bf16x8*)(kdst + (4 * i) * 272) = tk[i];
#pragma unroll
          for (int i = 0; i < 8; ++i) *(LAS bf16x8*)(dst + (4 * i) * 288) = tmp[i];
        }
        asm volatile("" ::: "memory");
        f32x16 p0;
#pragma unroll
        for (int r = 0; r < 16; ++r) p0[r] = 0.f;
        { const LAS unsigned char* kf = wl + 9216 + km * 272 + 16 * hi;
          LDS_WAIT();
#pragma unroll
          for (int ks = 0; ks < 8; ++ks) { const bf16x8 a0 = *(const LAS bf16x8*)(kf + 32 * ks); p0 = __builtin_amdgcn_mfma_f32_32x32x16_bf16(a0, qf[ks], p0, 0, 0, 0); } }
        f32x16 s0;
#pragma unroll
        for (int r = 0; r < 16; ++r) s0[r] = softplus2(p0[r]);
        if (kt == ktop) {
#pragma unroll
            for (int r = 0; r < 16; ++r) { const int key0 = k0 + 16 * (r >> 3) + 8 * hi + (r & 7);
                if (key0 >= t) { s0[r] = 0.f; p0[r] = -__builtin_inff(); } }
        }
        float T0 = 0.f, T1 = 0.f;
#pragma unroll
        for (int r = 0; r < 8; ++r) { T0 += s0[r]; T1 += s0[8 + r]; }
        const float U0 = __shfl_xor(T0, 32), U1 = __shfl_xor(T1, 32);
        const float b1 = C, b0 = b1 + T1 + U1;
        const float Cn = b0 + T0 + U0;
        float run1 = b1 + (hi ? 0.f : U1), run0 = b0 + (hi ? 0.f : U0);
#pragma unroll
        for (int r = 7; r >= 0; --r) {
            run1 += s0[8 + r]; p0[8 + r] = __builtin_amdgcn_exp2f(p0[8 + r] - run1);
            run0 += s0[r];     p0[r]     = __builtin_amdgcn_exp2f(p0[r] - run0);
        }
        C = Cn;
        bf16x8 pf[2];
        { u32x4 w;
          w.x = pk2(p0[0], p0[1]); w.y = pk2(p0[2], p0[3]); w.z = pk2(p0[4], p0[5]); w.w = pk2(p0[6], p0[7]); pf[0] = __builtin_bit_cast(bf16x8, w);
          w.x = pk2(p0[8], p0[9]); w.y = pk2(p0[10], p0[11]); w.z = pk2(p0[12], p0[13]); w.w = pk2(p0[14], p0[15]); pf[1] = __builtin_bit_cast(bf16x8, w); }
        LDS_WAIT();
#pragma unroll
        for (int c = 0; c < 4; ++c)
#pragma unroll
            for (int ks = 0; ks < 2; ++ks) {
                const s16x4 lo = vtr(vbase + (16 * ks) * 288 + c * 64), hh = vtr(vbase + (16 * ks + 4) * 288 + c * 64);
                const bf16x8 vf = (bf16x8){lo[0], lo[1], lo[2], lo[3], hh[0], hh[1], hh[2], hh[3]};
                o[c] = __builtin_amdgcn_mfma_f32_32x32x16_bf16(pf[ks], vf, o[c], 0, 0, 0);
            }
        LDS_WAIT();
        if (__all(C >= 151.0f)) break;
    }
    bf16* op = AO + (rowbase + t0) * D + h * 128 + (lane & 31);
#pragma unroll
    for (int c = 0; c < 4; ++c)
#pragma unroll
        for (int r = 0; r < 16; ++r) { const int row = (r & 3) + 8 * (r >> 2) + 4 * hi; op[(size_t)row * D + 32 * c] = (bf16)(pk2(o[c][r], 0.f) & 0xffffu); }
}

__device__ __forceinline__ unsigned fkey(float f) { const unsigned u = __builtin_bit_cast(unsigned, f); return (u & 0x80000000u) ? ~u : (u | 0x80000000u); }
__device__ __forceinline__ int mbcnt(unsigned long long m) { return __builtin_amdgcn_mbcnt_hi((unsigned)(m >> 32), __builtin_amdgcn_mbcnt_lo((unsigned)m, 0u)); }

#define PIN8(m) asm volatile("" : "+s"(m[0]), "+s"(m[1]), "+s"(m[2]), "+s"(m[3]), "+s"(m[4]), "+s"(m[5]), "+s"(m[6]), "+s"(m[7]))
__device__ __forceinline__ void select_query(const float* sc, int* sel, int ce, int lane) {
    const int nreg = ce >> 6;
    unsigned key[64];
    {
        float raw[64];
#pragma unroll
        for (int g = 0; g < 8; ++g) {
            if (8 * g < nreg) {
#pragma unroll
                for (int j = 8 * g; j < 8 * g + 8; ++j) raw[j] = sc[lane + 64 * j];
            } else {
#pragma unroll
                for (int j = 8 * g; j < 8 * g + 8; ++j) raw[j] = 0.f;
            }
        }
#pragma unroll
        for (int j = 0; j < 64; ++j) key[j] = (j < nreg) ? fkey(raw[j]) : 0u;
    }
    unsigned prefix = 0u; bool exact = false;
    for (int bit = 31; bit >= 0; --bit) {
        const unsigned cand = prefix | (1u << bit);
        int cnt = 0;
#pragma unroll
        for (int g = 0; g < 8; ++g) if (8 * g < nreg) {
            unsigned long long m[8];
#pragma unroll
            for (int j = 0; j < 8; ++j) m[j] = __ballot(key[8 * g + j] >= cand);
            PIN8(m);
#pragma unroll
            for (int j = 0; j < 8; ++j) cnt += __builtin_popcountll(m[j]);
            asm volatile("" : "+s"(cnt));
        }
        if (cnt >= 256) prefix = cand;
        if (cnt == 256) { exact = true; break; }
    }
    const unsigned thr = exact ? prefix - 1u : prefix;
    int pos = 0;
#pragma unroll
    for (int g = 0; g < 8; ++g) if (8 * g < nreg) {
        unsigned long long m[8];
#pragma unroll
        for (int j = 0; j < 8; ++j) m[j] = __ballot(key[8 * g + j] > thr);
        PIN8(m);
#pragma unroll
        for (int j = 0; j < 8; ++j) { if (key[8 * g + j] > thr) sel[pos + mbcnt(m[j])] = lane + 64 * (8 * g + j); pos += __builtin_popcountll(m[j]); }
        asm volatile("" : "+s"(pos));
    }
    int need = 256 - pos;
    if (need > 0)
#pragma unroll
    for (int g = 0; g < 8; ++g) if (8 * g < nreg) {
        unsigned long long m[8];
#pragma unroll
        for (int j = 0; j < 8; ++j) m[j] = __ballot(key[8 * g + j] == prefix);
        PIN8(m);
#pragma unroll
        for (int j = 0; j < 8; ++j) { const int rank = mbcnt(m[j]);
            if (key[8 * g + j] == prefix && rank < need) sel[pos + rank] = lane + 64 * (8 * g + j);
            const int c = __builtin_popcountll(m[j]); const int take = c < need ? c : need; pos += take; need -= take; }
        asm volatile("" : "+s"(pos), "+s"(need));
    }
}

__device__ __forceinline__ void idx_unit(bf16* QB, float* SC, int* SEL, const float* qg, const float* kg, int b, int tp, LAS unsigned char* wl, int lane, bool do_norm) {
    const int t = 4 * tp; const size_t rowbase = (size_t)b * SEQ; const size_t row = rowbase + t;
    const int n = lane & 31, hi = lane >> 5;
    const int ce = ((t >> 6) + 1) << 6;
    if (ce > 256) {
        bf16x8 af[2][4];
#pragma unroll
        for (int q2 = 0; q2 < 2; ++q2) { const bf16* ap = QB + (row + 2 * q2 + (n >> 4)) * NBP + CQI + (n & 15) * 64 + 8 * hi;
#pragma unroll
          for (int ks = 0; ks < 4; ++ks) af[q2][ks] = *(const bf16x8*)(ap + 16 * ks); }
        float w[4][8];
#pragma unroll
        for (int a = 0; a < 4; ++a)
#pragma unroll
            for (int r = 0; r < 8; ++r) { const int hh = (r & 3) + 8 * (r >> 2) + 4 * hi; w[a][r] = 0.25f * bflo((unsigned)QB[(row + a) * NBP + CWI + hh]); }
        float* scw0 = SC + (row + hi) * SEQ + n; float* scw1 = scw0 + 2 * (size_t)SEQ;
        const int r8 = lane >> 3, c8 = lane & 7;
        const bf16* kg8 = QB + (rowbase + r8) * NBP + CKI + c8 * 8;
        LAS unsigned char* sdst = wl + r8 * 144 + c8 * 16;
        const LAS unsigned char* fsrc = wl + n * 144 + 16 * hi;
        bf16x8 cur[8];
#pragma unroll
        for (int i = 0; i < 8; ++i) cur[i] = *(const bf16x8*)(kg8 + (size_t)(8 * i) * NBP);
        for (int s0 = 0; s0 < ce; s0 += 64) {
#pragma unroll
            for (int i = 0; i < 8; ++i) *(LAS bf16x8*)(sdst + (8 * i) * 144) = cur[i];
            const int sn = (s0 + 64 < ce) ? s0 + 64 : 0;
#pragma unroll
            for (int i = 0; i < 8; ++i) cur[i] = *(const bf16x8*)(kg8 + (size_t)(sn + 8 * i) * NBP);
            LDS_WAIT();
#pragma unroll
            for (int tt = 0; tt < 2; ++tt) {
                f32x16 acc0, acc1;
#pragma unroll
                for (int r = 0; r < 16; ++r) { acc0[r] = 0.f; acc1[r] = 0.f; }
#pragma unroll
                for (int ks = 0; ks < 4; ++ks) { const bf16x8 bfr = *(const LAS bf16x8*)(fsrc + tt * 32 * 144 + 32 * ks);
                    acc0 = __builtin_amdgcn_mfma_f32_32x32x16_bf16(af[0][ks], bfr, acc0, 0, 0, 0); acc1 = __builtin_amdgcn_mfma_f32_32x32x16_bf16(af[1][ks], bfr, acc1, 0, 0, 0); }
                float pa = 0.f, pb = 0.f, pc = 0.f, pd = 0.f;
#pragma unroll
                for (int r = 0; r < 8; ++r) { pa += w[0][r] * (__builtin_fmaxf(acc0[r], 0.f) * 0.125f); pb += w[1][r] * (__builtin_fmaxf(acc0[8 + r], 0.f) * 0.125f);
                                              pc += w[2][r] * (__builtin_fmaxf(acc1[r], 0.f) * 0.125f); pd += w[3][r] * (__builtin_fmaxf(acc1[8 + r], 0.f) * 0.125f); }
                const float snd0 = hi ? pa : pb, snd1 = hi ? pc : pd; const float rcv0 = __shfl_xor(snd0, 32), rcv1 = __shfl_xor(snd1, 32);
                scw0[s0 + 32 * tt] = (hi ? pb : pa) + rcv0;
                scw1[s0 + 32 * tt] = (hi ? pd : pc) + rcv1;
            }
            LDS_WAIT();
        }
        __builtin_amdgcn_fence(__ATOMIC_SEQ_CST, "workgroup");
        asm volatile("s_waitcnt vmcnt(0)" ::: "memory");
#pragma unroll 1
        for (int a = 0; a < 4; ++a) select_query(SC + (row + a) * SEQ, SEL + (row + a) * 256, ce, lane);
    } else {
#pragma unroll
        for (int i = 0; i < 4; ++i) { const int p = lane + 64 * i; if (p < ce) {
#pragma unroll
            for (int a = 0; a < 4; ++a) SEL[(row + a) * 256 + p] = p; } }
    }
    if (!do_norm) return;
    const int lg = lane >> 4, li = lane & 15;
#pragma unroll 1
    for (int a = 0; a < 4; ++a)
#pragma unroll 1
        for (int p = 0; p < 5; ++p) {
            const int col = (p < 4) ? (CQ + (4 * p + lg) * 128) : (CK + lg * 128);
            bf16* ptr = QB + (row + a) * NBP + col + 8 * li;
            const u32x4 w = *(const u32x4*)ptr;
            float v[8] = {bflo(w.x), bfhi(w.x), bflo(w.y), bfhi(w.y), bflo(w.z), bfhi(w.z), bflo(w.w), bfhi(w.w)};
            float s = 0.f;
#pragma unroll
            for (int e = 0; e < 8; ++e) s += v[e] * v[e];
            s += __shfl_xor(s, 1); s += __shfl_xor(s, 2); s += __shfl_xor(s, 4); s += __shfl_xor(s, 8);
            const float rstd = (1.0f / sqrtf(s * (1.f / 128.f) + RMS_EPS)) * ((p < 4) ? C2 : 1.f);
            const float* gp = ((p < 4) ? qg : kg) + 8 * li;
            const f32x4 g0 = *(const f32x4*)gp, g1 = *(const f32x4*)(gp + 4);
            u32x4 o; o.x = pk2(v[0] * rstd * g0.x, v[1] * rstd * g0.y); o.y = pk2(v[2] * rstd * g0.z, v[3] * rstd * g0.w);
            o.z = pk2(v[4] * rstd * g1.x, v[5] * rstd * g1.y); o.w = pk2(v[6] * rstd * g1.z, v[7] * rstd * g1.w);
            *(u32x4*)ptr = o;
        }
}

__device__ __forceinline__ int t5_bucket(int rel) {
    const int nabs = rel < 0 ? -rel : rel;
    int bk = nabs;
    if (nabs >= 8) bk = 8 + (nabs >= 12) + (nabs >= 16) + (nabs >= 23) + (nabs >= 32) + (nabs >= 46) + (nabs >= 64) + (nabs >= 91);
    return bk + (rel > 0 ? 16 : 0);
}
typedef float f32x4v __attribute__((ext_vector_type(4)));
__device__ __forceinline__ void dsa_unit(const bf16* QB, const int* SEL, bf16* AO, int b, int kvh, int t, LAS unsigned char* wl, int lane) {
    const size_t rowbase = (size_t)b * SEQ, row = rowbase + t;
    const int n = lane & 31, hi = lane >> 5, l15 = lane & 15, kq = lane >> 4;
    const int ce = ((t >> 6) + 1) << 6; const int nsel = ce < 256 ? ce : 256;
    LAS unsigned char* buf = wl;
    LAS bf16* pT = (LAS bf16*)(wl + 9216);
    LAS int* il = (LAS int*)(wl + 11264);
    const LAS float* bl = (const LAS float*)(wl + 12288) + kvh * 128;
    int sidx[8];
#pragma unroll
    for (int kb = 0; kb < 8; ++kb) { const int p = 32 * kb + n; sidx[kb] = (p < nsel) ? SEL[row * 256 + p] : 0; }
    bf16x8 qf[4];
    { const bf16* qp = QB + row * NBP + CQ + (kvh * 4 + (l15 & 3)) * 128 + 8 * kq;
#pragma unroll
      for (int ks = 0; ks < 4; ++ks) qf[ks] = *(const bf16x8*)(qp + 32 * ks); }
    if (hi == 0) {
#pragma unroll
        for (int kb = 0; kb < 8; ++kb) il[32 * kb + n] = sidx[kb];
    }
    LDS_WAIT();
    const int r4 = kq, c16 = l15;
    const bf16* kg = QB + rowbase * NBP + CK + kvh * 128 + c16 * 8;
    const bf16* vg = QB + rowbase * NBP + CV + kvh * 128 + c16 * 8;
    bf16x8 kr[3][8];
#pragma unroll
    for (int pb = 0; pb < 3; ++pb)
#pragma unroll
        for (int i = 0; i < 8; ++i) kr[pb][i] = *(const bf16x8*)(kg + (size_t)il[32 * pb + 4 * i + r4] * NBP);
    float lg[8][4];
    float mx[4] = {-__builtin_inff(), -__builtin_inff(), -__builtin_inff(), -__builtin_inff()};
    LAS unsigned char* kdst = buf + r4 * 272 + c16 * 16;
    const LAS unsigned char* kfb = buf + l15 * 272 + 16 * kq;
    const bool upper = (lane >> 4) & 1;
#pragma unroll
    for (int kb = 0; kb < 8; ++kb) {
#pragma unroll
        for (int i = 0; i < 8; ++i) *(LAS bf16x8*)(kdst + (4 * i) * 272) = kr[kb % 3][i];
        if (kb + 3 < 8) {
#pragma unroll
            for (int i = 0; i < 8; ++i) kr[kb % 3][i] = *(const bf16x8*)(kg + (size_t)il[32 * (kb + 3) + 4 * i + r4] * NBP);
        }
        LDS_WAIT();
        f32x4v a0 = {0.f, 0.f, 0.f, 0.f}, a1 = {0.f, 0.f, 0.f, 0.f};
#pragma unroll
        for (int ks = 0; ks < 4; ++ks) { const bf16x8 b0 = *(const LAS bf16x8*)(kfb + 64 * ks), b1 = *(const LAS bf16x8*)(kfb + 16 * 272 + 64 * ks);
            a0 = __builtin_amdgcn_mfma_f32_16x16x32_bf16(qf[ks], b0, a0, 0, 0, 0); a1 = __builtin_amdgcn_mfma_f32_16x16x32_bf16(qf[ks], b1, a1, 0, 0, 0); }
        LDS_WAIT();
        const int bk = t5_bucket(sidx[kb] - t);
        const bool valid = (32 * kb + n) < nsel;
#pragma unroll
        for (int g = 0; g < 4; ++g) { const float raw = upper ? a1[g] : a0[g]; const float v = valid ? raw + bl[g * 32 + bk] : -__builtin_inff(); lg[kb][g] = v; mx[g] = __builtin_fmaxf(mx[g], v); }
    }
    bf16x8 vr[3][8];
#pragma unroll
    for (int pb = 0; pb < 3; ++pb)
#pragma unroll
        for (int i = 0; i < 8; ++i) vr[pb][i] = *(const bf16x8*)(vg + (size_t)il[32 * pb + 4 * i + r4] * NBP);
#pragma unroll
    for (int g = 0; g < 4; ++g) {
        float m = mx[g];
        m = __builtin_fmaxf(m, __shfl_xor(m, 1)); m = __builtin_fmaxf(m, __shfl_xor(m, 2)); m = __builtin_fmaxf(m, __shfl_xor(m, 4)); m = __builtin_fmaxf(m, __shfl_xor(m, 8)); m = __builtin_fmaxf(m, __shfl_xor(m, 16));
        float s = 0.f;
#pragma unroll
        for (int kb = 0; kb < 8; ++kb) { const float e = __builtin_amdgcn_exp2f(lg[kb][g] - m); lg[kb][g] = e; s += e; }
        s += __shfl_xor(s, 1); s += __shfl_xor(s, 2); s += __shfl_xor(s, 4); s += __shfl_xor(s, 8); s += __shfl_xor(s, 16);
        const float inv = 1.0f / s;
#pragma unroll
        for (int kb = 0; kb < 8; ++kb) if ((kb >> 2) == hi) pT[g * 256 + 32 * kb + n] = (bf16)(pk2(lg[kb][g] * inv, 0.f) & 0xffffu);
    }
    f32x4v o[8];
#pragma unroll
    for (int c = 0; c < 8; ++c) o[c] = (f32x4v){0.f, 0.f, 0.f, 0.f};
    const LAS unsigned char* vtb = buf + (8 * kq + (l15 >> 2)) * 288 + (lane & 3) * 8;
    LAS unsigned char* vdst = buf + r4 * 288 + c16 * 16;
    const LAS bf16* pfp = pT + (l15 & 3) * 256 + 8 * kq;
#pragma unroll
    for (int ch = 0; ch < 8; ++ch) {
#pragma unroll
        for (int i = 0; i < 8; ++i) *(LAS bf16x8*)(vdst + (4 * i) * 288) = vr[ch % 3][i];
        if (ch + 3 < 8) {
#pragma unroll
            for (int i = 0; i < 8; ++i) vr[ch % 3][i] = *(const bf16x8*)(vg + (size_t)il[32 * (ch + 3) + 4 * i + r4] * NBP);
        }
        const bf16x8 pf = *(const LAS bf16x8*)(pfp + 32 * ch);
        LDS_WAIT();
#pragma unroll
        for (int c = 0; c < 8; ++c) {
            const s16x4 lo = vtr(vtb + c * 32), hh = vtr(vtb + 4 * 288 + c * 32);
            o[c] = __builtin_amdgcn_mfma_f32_16x16x32_bf16(pf, (bf16x8){lo[0], lo[1], lo[2], lo[3], hh[0], hh[1], hh[2], hh[3]}, o[c], 0, 0, 0);
        }
        LDS_WAIT();
    }
    bf16* op = AO + row * D + (kvh * 4) * 128 + 16 * kq + l15;
#pragma unroll
    for (int i = 0; i < 2; ++i)
#pragma unroll
        for (int g = 0; g < 4; ++g) {
            const float v = (kq == 0) ? o[4 * i][g] : (kq == 1) ? o[4 * i + 1][g] : (kq == 2) ? o[4 * i + 2][g] : o[4 * i + 3][g];
            op[g * 128 + 64 * i] = (bf16)(pk2(v, 0.f) & 0xffffu);
        }
}

__device__ __forceinline__ unsigned xcc_id() { return (unsigned)__builtin_amdgcn_s_getreg((3 << 11) | 20) & 0xFu; }
__device__ __forceinline__ void grid_barrier(unsigned* bar, unsigned round, unsigned xcc, unsigned gsz, unsigned nx) {
    asm volatile("s_waitcnt vmcnt(0) lgkmcnt(0)" ::: "memory");
    __syncthreads();
    if (threadIdx.x == 0) {
        const unsigned old = __hip_atomic_fetch_add(bar + 64 * (1 + xcc), 1u, __ATOMIC_RELAXED, __HIP_MEMORY_SCOPE_AGENT);
        if (old + 1u == gsz * round) {
            __builtin_amdgcn_fence(__ATOMIC_RELEASE, "agent");
            asm volatile("s_waitcnt vmcnt(0)" ::: "memory");
            __hip_atomic_fetch_add(bar, 1u, __ATOMIC_RELAXED, __HIP_MEMORY_SCOPE_AGENT);
        }
        while (__hip_atomic_load(bar, __ATOMIC_RELAXED, __HIP_MEMORY_SCOPE_AGENT) < nx * round) __builtin_amdgcn_s_sleep(1);
        __builtin_amdgcn_fence(__ATOMIC_ACQUIRE, "agent");
        asm volatile("s_waitcnt vmcnt(0)" ::: "memory");
    }
    __syncthreads();
}

struct Args { const float* in[12]; float* out; unsigned char* ws; int ph_lo, ph_hi; };
enum { I_X = 0, I_NMIX, I_WINA, I_WOUTA, I_WINB, I_WOUTB, I_QN, I_KN, I_RELB, I_NMLP, I_WUP, I_WDOWN };

__global__ void __launch_bounds__(NWAVES * 64, 2) fwd_megakernel(Args args) {
    extern __shared__ __attribute__((aligned(16))) unsigned char lds_raw[];
    LAS unsigned char* lds = (LAS unsigned char*)lds_raw;
    cg::grid_group grid = cg::this_grid();
    const int wave = __builtin_amdgcn_readfirstlane((int)threadIdx.x >> 6);
    const int G = gridDim.x, gw = blockIdx.x * NWAVES + wave, ngw = G * NWAVES;
    LAS unsigned char* wl = lds + wave * WLDS;
    unsigned char* ws = args.ws;
    const float* x_in = args.in[I_X];
    float* xres = args.out;
    bf16* XN = (bf16*)(ws + WS_XN); bf16* QKV = (bf16*)(ws + WS_QKV); bf16* AO = (bf16*)(ws + WS_AO); bf16* HB = (bf16*)(ws + WS_HB);
    int* SEL = (int*)(ws + WS_SEL); float* SC = (float*)(ws + WS_SC);
    const int lo = args.ph_lo, hi = args.ph_hi;
    int ph = 0;
    unsigned* bar_ctr = (unsigned*)ws; unsigned bar_target = 0u; const unsigned bar_xcc = xcc_id(); unsigned bar_gsz = 1u, bar_nx = 1u;
#define PH_BEGIN if (ph >= lo && ph < hi) { int lane = __builtin_amdgcn_mbcnt_hi(~0u, __builtin_amdgcn_mbcnt_lo(~0u, 0u)); asm volatile("" : "+v"(lane));
#define PH_END if (ph + 1 < hi) { for (int rsy = 0; rsy < REP_SYNC; ++rsy) { if (ph == lo) { grid.sync(); unsigned c_ = 0u, n_ = 0u; if (wave == 0) for (unsigned j_ = 0; j_ < 16u; ++j_) { const unsigned v_ = __hip_atomic_load(bar_ctr + 64 * (17 + j_), __ATOMIC_RELAXED, __HIP_MEMORY_SCOPE_AGENT); n_ += (v_ != 0u); if (j_ == bar_xcc) c_ = v_; } bar_gsz = __builtin_amdgcn_readfirstlane(c_); bar_nx = __builtin_amdgcn_readfirstlane(n_); } else { bar_target += 1u; grid_barrier(bar_ctr, bar_target, bar_xcc, bar_gsz, bar_nx); } } } } ++ph;

    PH_BEGIN
    {
        LAS float* scr = (LAS float*)wl;
        constexpr int I_A = 32 * (NAIN / 32), I_O = 32 * (D / 32), I_B = 32 * (NBP / 32), I_U = 32 * (FF / 32), I_DN = (FF / 64) * (D / 32);
        constexpr int NITEMS = 2 * I_A + 2 * I_O + 2 * I_B + 2 * I_O + 4 * I_U + 4 * I_DN;
        auto decode = [&](int it) -> TItem {
            int r = it; const float* W; bf16* WT; int K, N, Np, l, q;
            if (r < 2 * I_A) { l = r / I_A; q = r % I_A; W = args.in[I_WINA] + (size_t)l * D * NAIN; WT = (bf16*)(ws + WS_WINA) + (size_t)l * NAIN * D; K = D; N = NAIN; Np = NAIN; }
            else if ((r -= 2 * I_A) < 2 * I_O) { l = r / I_O; q = r % I_O; W = args.in[I_WOUTA] + (size_t)l * D * D; WT = (bf16*)(ws + WS_WOUTA) + (size_t)l * D * D; K = D; N = D; Np = D; }
            else if ((r -= 2 * I_O) < 2 * I_B) { l = r / I_B; q = r % I_B; W = args.in[I_WINB] + (size_t)l * D * NBIN; WT = (bf16*)(ws + WS_WINB) + (size_t)l * NBP * D; K = D; N = NBIN; Np = NBP; }
            else if ((r -= 2 * I_B) < 2 * I_O) { l = r / I_O; q = r % I_O; W = args.in[I_WOUTB] + (size_t)l * D * D; WT = (bf16*)(ws + WS_WOUTB) + (size_t)l * D * D; K = D; N = D; Np = D; }
            else if ((r -= 2 * I_O) < 4 * I_U) { l = r / I_U; q = r % I_U; W = args.in[I_WUP] + (size_t)l * D * FF; WT = (bf16*)(ws + WS_WUP) + (size_t)l * FF * D; K = D; N = FF; Np = FF; }
            else { r -= 4 * I_U; l = r / I_DN; q = r % I_DN; W = args.in[I_WDOWN] + (size_t)l * FF * D; WT = (bf16*)(ws + WS_WDOWN) + (size_t)l * D * FF; K = FF; N = D; Np = D; }
            const int nblk = Np / 32; TItem t; t.W = W; t.WT = WT; t.K = K; t.N = N; t.k0 = 64 * (q / nblk); t.n0 = 32 * (q % nblk); return t; };
        float tv[32];
        if (gw < NITEMS) { const TItem t0 = decode(gw); titem_load(t0, lane, tv); }
        for (int rep = 0; rep < REP_PRO; ++rep)
        for (int it = gw; it < NITEMS; it += ngw) {
            const TItem t = decode(it);
            titem_to_lds(t, lane, tv, scr);
            { const int nx = (it + ngw < NITEMS) ? it + ngw : it; const TItem tn = decode(nx); titem_load(tn, lane, tv); }
            LDS_WAIT();
            titem_store(t, lane, scr);
            LDS_WAIT();
        }
        norm_phase(x_in, args.in[I_NMIX], XN, gw, ngw, lane);
        if (wave == 0 && lane == 0) __hip_atomic_fetch_add(bar_ctr + 64 * (17 + bar_xcc), 1u, __ATOMIC_RELAXED, __HIP_MEMORY_SCOPE_AGENT);
        { unsigned long long* z = (unsigned long long*)(ws + WS_RSS); for (int i = gw * 64 + lane; i < 8 * M; i += ngw * 64) __hip_atomic_store(z + i, 0ull, __ATOMIC_RELAXED, __HIP_MEMORY_SCOPE_AGENT); }
        __syncthreads();
    }
    PH_END

#pragma unroll 1
    for (int L = 0; L < DEPTH; ++L) {
        const int j = L >> 1; const bool isA = (L & 1) == 0;
        const float* xbase = (L == 0) ? x_in : xres;
        unsigned long long* rss_all = (unsigned long long*)(ws + WS_RSS);
        const unsigned long long* rss_mix = (L == 0) ? (const unsigned long long*)nullptr : rss_all + (size_t)(2 * L - 1) * M;
        unsigned long long* rss_mlp = rss_all + (size_t)(2 * L) * M; unsigned long long* rss_next = rss_all + (size_t)(2 * L + 1) * M;
        PH_BEGIN
        if (isA) {
            pg8::Gemm g{XN, (const bf16*)(ws + WS_WINA) + (size_t)j * NAIN * D, M, NAIN, D}; pg8::StaticOrder S; S.init(M, NAIN, G, (int)blockIdx.x);
            pg8::EpiBf16<0> E{QKV, NAIN, D, C2, rss_mix};
            pg8::gemm_phase<pg8::EpiBf16<0>, pg8::StaticOrder, true, true>(lds, g, S, E, wave);
        } else {
            pg8::Gemm g{XN, (const bf16*)(ws + WS_WINB) + (size_t)j * NBP * D, M, NBP, D}; pg8::StaticOrder S; S.init(M, NBP, G, (int)blockIdx.x);
            pg8::EpiBf16<0> E{QKV, NBP, 0, 1.f, rss_mix};
            pg8::gemm_phase<pg8::EpiBf16<0>, pg8::StaticOrder, true, true>(lds, g, S, E, wave);
        }
        PH_END
        if (isA) {
            PH_BEGIN
            for (int rep = 0; rep < REP_SB; ++rep) for (int u = gw; u < NBATCH * 16 * (SEQ / 32); u += ngw) { const int qblk = u % (SEQ / 32), bh = u / (SEQ / 32);
#ifndef NO_SB
 sb_unit(QKV, AO, bh >> 4, bh & 15, qblk, wl, lane);
#endif
 }
            __syncthreads();
            PH_END
        } else {
            PH_BEGIN
            {
                const int per = SEQ / 4;
                for (int rep = 0; rep < REP_IDX; ++rep) for (int i = 0; i * ngw < NBATCH * per; ++i) { const int u = i * ngw + gw; if (u >= NBATCH * per) break;
                    const int bb = u / per; int tp = u % per; if (i & 1) tp = per - 1 - tp;

#ifndef NO_IDX
 idx_unit(QKV, SC, SEL, args.in[I_QN] + j * 128, args.in[I_KN] + j * 128, bb, tp, wl, lane, rep == REP_IDX - 1);
#endif
 }
                __syncthreads();
            }
            PH_END
            PH_BEGIN
            {
                { LAS float* blw = (LAS float*)(wl + 12288);
#pragma unroll
                  for (int i = 0; i < 8; ++i) blw[lane + 64 * i] = LOG2E * args.in[I_RELB][lane + 64 * i];
                  LDS_WAIT(); }
                for (int rep = 0; rep < REP_DSA; ++rep)
                if ((G & 7) == 0) { const int x = blockIdx.x & 7; const int nxw = (G >> 3) * NWAVES; const int wx = (blockIdx.x >> 3) * NWAVES + wave;
                    for (int i = wx; i < 2 * SEQ; i += nxw) { const int combo = x + 8 * (i / SEQ);
#ifndef NO_DSA
 dsa_unit(QKV, SEL, AO, combo >> 2, combo & 3, i % SEQ, wl, lane);
#endif
 } }
                else { for (int i = gw; i < 16 * SEQ; i += ngw) { const int combo = i / SEQ;
#ifndef NO_DSA
 dsa_unit(QKV, SEL, AO, combo >> 2, combo & 3, i % SEQ, wl, lane);
#endif
 } }
                __syncthreads();
            }
            PH_END
        }
        PH_BEGIN
        {
            const bf16* wo = isA ? (const bf16*)(ws + WS_WOUTA) + (size_t)j * D * D : (const bf16*)(ws + WS_WOUTB) + (size_t)j * D * D;
            pg8::Gemm g{AO, wo, M, D, D}; pg8::StaticOrder S; S.init(M, D, G, (int)blockIdx.x);
            pg8::EpiResid E{xbase, xres, D, args.in[I_NMLP] + (size_t)L * D, XN, rss_mlp};
            pg8::gemm_phase<pg8::EpiResid, pg8::StaticOrder, true, true>(lds, g, S, E, wave);
        }
        PH_END
        PH_BEGIN
        {
            pg8::Gemm g{XN, (const bf16*)(ws + WS_WUP) + (size_t)L * FF * D, M, FF, D}; pg8::StaticOrder S; S.init(M, FF, G, (int)blockIdx.x);
            pg8::EpiBf16<1> E{HB, FF, 0, 1.f, rss_mlp};
            for (int rep = 0; rep < REP_UP; ++rep) pg8::gemm_phase<pg8::EpiBf16<1>, pg8::StaticOrder, true, true>(lds, g, S, E, wave);
        }
        PH_END
        PH_BEGIN
        {
            pg8::Gemm g{HB, (const bf16*)(ws + WS_WDOWN) + (size_t)L * D * FF, M, D, FF}; pg8::StaticOrder S; S.init(M, D, G, (int)blockIdx.x);
            pg8::EpiResid E{xres, xres, D, (L + 1 < DEPTH) ? args.in[I_NMIX] + (size_t)(L + 1) * D : (const float*)nullptr, XN, rss_next};
            pg8::gemm_phase<pg8::EpiResid, pg8::StaticOrder, true, true>(lds, g, S, E, wave);
        }
        PH_END
    }
#undef PH_BEGIN
#undef PH_END
}

#ifndef MK_MULTI
#define MK_MULTI 0
#endif
constexpr int N_PHASES = 1 + 5 + 6 + 5 + 6;

extern "C" void kernel_launch(void* const* d_in, const int* in_sizes, int n_in, void* d_out, int out_size, void* d_ws, size_t ws_size, hipStream_t stream) {
    static int grid = 0;
    if (grid == 0) {
        if (n_in != 12 || out_size != M * D || ws_size < WS_END) { fprintf(stderr, "kernel_launch: unexpected shapes (n_in %d out %d ws %zu)\n", n_in, out_size, ws_size); grid = -1; return; }
        int dev = 0, cus = 0, per_cu = 0;
        if (hipGetDevice(&dev) != hipSuccess || hipDeviceGetAttribute(&cus, hipDeviceAttributeMultiprocessorCount, dev) != hipSuccess) { grid = -1; return; }
        if (hipFuncSetAttribute((const void*)fwd_megakernel, hipFuncAttributeMaxDynamicSharedMemorySize, LDS_BYTES) != hipSuccess) { fprintf(stderr, "kernel_launch: hipFuncSetAttribute failed\n"); grid = -1; return; }
        if (hipOccupancyMaxActiveBlocksPerMultiprocessor(&per_cu, (const void*)fwd_megakernel, NWAVES * 64, LDS_BYTES) != hipSuccess || per_cu < 1) { fprintf(stderr, "kernel_launch: occupancy query gave %d\n", per_cu); per_cu = 1; }
        (void)hipGetLastError();
        grid = cus * per_cu;
    }
    if (grid < 0) return;
    Args a{};
    for (int i = 0; i < 12; ++i) a.in[i] = (const float*)d_in[i];
    a.out = (float*)d_out; a.ws = (unsigned char*)d_ws;
#if MK_MULTI
    for (int p = 0; p < N_PHASES; ++p) { a.ph_lo = p; a.ph_hi = p + 1; hipLaunchKernelGGL(fwd_megakernel, dim3(grid), dim3(NWAVES * 64), LDS_BYTES, stream, a); }
#else
    a.ph_lo = 0; a.ph_hi = N_PHASES;
    if (hipMemsetAsync(d_ws, 0, 16384, stream) != hipSuccess) { fprintf(stderr, "kernel_launch: memset of the barrier words failed\n"); return; }
    void* kargs[] = {&a};
    const hipError_t e = hipLaunchCooperativeKernel((const void*)fwd_megakernel, dim3(grid), dim3(NWAVES * 64), kargs, LDS_BYTES, stream);
    if (e != hipSuccess) fprintf(stderr, "kernel_launch: cooperative launch failed: %s (grid %d)\n", hipGetErrorString(e), grid);
#endif
}
```
